# Optimizing an MI355X kernel written in HIP

```python
import jax, jax.numpy as jnp
from jax import lax
import numpy as np

D_MODEL = 1024
BATCH = 8
SEQ = 4096
DEPTH = 2

CHUNK = 64
QBLOCK = 128
MEM_LEN = 256
EPS = 1e-6
FOX_HEADS = 4
FOX_HD = 64
GLA_HEADS = 4
GLA_DK = 64
GLA_DV = 128
GLA_GATE_RANK = 16
GLA_TAU = 16.0
MLA_HEADS = 4
MLA_Q_RANK = 256
MLA_KV_RANK = 128
MLA_NOPE = 64
MLA_ROPE = 32
MLA_VD = 64
ROPE_BASE = 10000.0
XA_HEADS = 4
XA_HD = 128
D_FF = 4 * D_MODEL
N_BRANCH = 3

FOX_W = FOX_HEADS * FOX_HD
GLA_K_W = GLA_HEADS * GLA_DK
GLA_V_W = GLA_HEADS * GLA_DV
MLA_QK_HD = MLA_NOPE + MLA_ROPE
MLA_W = MLA_HEADS * MLA_VD
XA_W = XA_HEADS * XA_HD

IN_SIZES = (FOX_W, FOX_W, FOX_W, FOX_HEADS,
            GLA_K_W, GLA_K_W, GLA_V_W, GLA_GATE_RANK, GLA_V_W,
            MLA_Q_RANK, MLA_KV_RANK, MLA_ROPE,
            N_BRANCH * D_MODEL)
N_IN = sum(IN_SIZES)

kernel_name = 'hybrid_fox_gla_mla_gated_encoder'

F32 = jnp.float32


def rms_norm(x, g):
    xf = x.astype(F32)
    y = xf * lax.rsqrt(jnp.mean(xf * xf, axis=-1, keepdims=True) + EPS)
    return (y * g.astype(F32)).astype(x.dtype)


def split_heads(z, n):
    b, s, w = z.shape
    return z.reshape(b, s, n, w // n).transpose(0, 2, 1, 3)


def merge_heads(z):
    b, h, s, d = z.shape
    return z.transpose(0, 2, 1, 3).reshape(b, s, h * d)


def split_cols(z, sizes):
    out, start = [], 0
    for n in sizes:
        out.append(z[..., start:start + n])
        start += n
    return out


def rope(x, pos):
    half = x.shape[-1] // 2
    inv = ROPE_BASE ** (-jnp.arange(half, dtype=F32) / half)
    ang = pos.astype(F32)[:, None] * inv[None, :]
    cos, sin = jnp.cos(ang), jnp.sin(ang)
    xf = x.astype(F32)
    x1, x2 = xf[..., :half], xf[..., half:]
    return jnp.concatenate([x1 * cos - x2 * sin, x2 * cos + x1 * sin], axis=-1).astype(x.dtype)


def block_sweep_attention(q, k, v, scale, chunk_causal, log_decay=None):
    b, h, s, dk = q.shape
    nb = s // QBLOCK
    qb = q.reshape(b, h, nb, QBLOCK, dk).transpose(2, 0, 1, 3, 4)
    kpos = jnp.arange(s)
    idx = jnp.arange(nb)

    def one_block(args):
        i, qi = args[0], args[1]
        qpos = i * QBLOCK + jnp.arange(QBLOCK)
        logits = jnp.einsum('bhqd,bhkd->bhqk', qi, k, preferred_element_type=F32) * scale
        if log_decay is not None:
            logits = logits + args[2][..., :, None] - log_decay[:, :, None, :]
        limit = ((qpos // CHUNK) + 1) * CHUNK if chunk_causal else qpos + 1
        mask = kpos[None, :] < limit[:, None]
        p = jax.nn.softmax(jnp.where(mask, logits, -jnp.inf), axis=-1)
        return jnp.einsum('bhqk,bhkd->bhqd', p.astype(v.dtype), v)

    if log_decay is None:
        xs = (idx, qb)
    else:
        db = log_decay.reshape(b, h, nb, QBLOCK).transpose(2, 0, 1, 3)
        xs = (idx, qb, db)
    out = lax.map(one_block, xs)
    return out.transpose(1, 2, 0, 3, 4).reshape(b, h, s, v.shape[-1])


def fox_branch(q, k, v, f_logit, b_f):
    log_f = jax.nn.log_sigmoid(f_logit.astype(F32) + b_f.astype(F32))
    cum = jnp.cumsum(log_f, axis=1).transpose(0, 2, 1)
    o = block_sweep_attention(split_heads(q, FOX_HEADS), split_heads(k, FOX_HEADS),
                              split_heads(v, FOX_HEADS), FOX_HD ** -0.5,
                              chunk_causal=False, log_decay=cum)
    return merge_heads(o)


def gla_branch(q, k, v, g_low, r, w_gate, b_gate, g_out):
    b, s, _ = q.shape
    nc = s // CHUNK
    dt = q.dtype
    log_a = jax.nn.log_sigmoid((g_low @ w_gate + b_gate).astype(F32)) / GLA_TAU

    def chunks(z, d):
        return split_heads(z, GLA_HEADS).reshape(b, GLA_HEADS, nc, CHUNK, d)

    qc = chunks(q, GLA_DK).astype(F32) * (GLA_DK ** -0.5)
    kc = chunks(k, GLA_DK).astype(F32)
    vc = chunks(v, GLA_DV).astype(F32)
    cum = jnp.cumsum(chunks(log_a, GLA_DK), axis=3)
    end = cum[:, :, :, -1:, :]
    k_dec = kc * jnp.exp(end - cum)
    u = jnp.einsum('bhcld,bhcle->cbhde', k_dec, vc)
    a = jnp.exp(end[:, :, :, 0, :]).transpose(2, 0, 1, 3)

    def step(state, inp):
        u_c, a_c = inp
        state = a_c[..., None] * state + u_c
        return state, state

    _, states = lax.scan(step, jnp.zeros((b, GLA_HEADS, GLA_DK, GLA_DV), F32), (u, a))
    o = jnp.einsum('bhcld,cbhde->bhcle', qc, states).reshape(b, GLA_HEADS, s, GLA_DV)
    o = merge_heads(rms_norm(o, g_out)).astype(dt)
    return o * jax.nn.silu(r)


def mla_branch(c_q, c_kv, k_rope_in, g_q, w_uq, g_kv, w_ukv, pos):
    q = split_heads(rms_norm(c_q, g_q) @ w_uq, MLA_HEADS)
    kv = split_heads(rms_norm(c_kv, g_kv) @ w_ukv, MLA_HEADS)
    q_nope, q_rope = q[..., :MLA_NOPE], q[..., MLA_NOPE:]
    k_nope, v = kv[..., :MLA_NOPE], kv[..., MLA_NOPE:]
    k_rope = rope(k_rope_in, pos)[:, None]
    qh = jnp.concatenate([q_nope, rope(q_rope, pos)], axis=-1)
    kh = jnp.concatenate([k_nope, jnp.broadcast_to(k_rope, k_nope.shape[:-1] + (MLA_ROPE,))], axis=-1)
    o = block_sweep_attention(qh, kh, v, MLA_QK_HD ** -0.5, chunk_causal=True)
    return merge_heads(o)


def memory_cross_attention(h, m, w_xq, w_xkv, w_xo):
    q = split_heads(h @ w_xq, XA_HEADS)
    k, v = jnp.split(m @ w_xkv, 2, axis=-1)
    k, v = split_heads(k, XA_HEADS), split_heads(v, XA_HEADS)
    logits = jnp.einsum('bhqd,bhkd->bhqk', q, k, preferred_element_type=F32) * (XA_HD ** -0.5)
    p = jax.nn.softmax(logits, axis=-1)
    o = jnp.einsum('bhqk,bhkd->bhqd', p.astype(v.dtype), v)
    return merge_heads(o) @ w_xo


def setup_inputs(seed: int = 0) -> dict:
    key = jax.random.key(seed)
    ks = jax.random.split(key, 32)

    def dense(k, shape, fan_in):
        return jax.random.normal(k, shape, F32) * (fan_in ** -0.5)

    def gain(k, shape):
        return 1.0 + 0.02 * jax.random.normal(k, shape, F32)

    def bias(k, shape, scale):
        return scale * jax.random.normal(k, shape, F32)

    L, D = DEPTH, D_MODEL
    return {
        'x': jax.random.normal(ks[0], (BATCH, SEQ, D), F32),
        'mem': jax.random.normal(ks[1], (BATCH, MEM_LEN, D), F32),
        'g_mix': gain(ks[2], (L, D)),
        'w_in': dense(ks[3], (L, D, N_IN), D),
        'b_fox_forget': bias(ks[4], (L, FOX_HEADS), 0.1),
        'w_gla_gate': dense(ks[5], (L, GLA_GATE_RANK, GLA_K_W), GLA_GATE_RANK),
        'b_gla_gate': bias(ks[6], (L, GLA_K_W), 0.1),
        'g_gla_out': gain(ks[7], (L, GLA_DV)),
        'g_mla_q': gain(ks[8], (L, MLA_Q_RANK)),
        'w_mla_uq': dense(ks[9], (L, MLA_Q_RANK, MLA_HEADS * MLA_QK_HD), MLA_Q_RANK),
        'g_mla_kv': gain(ks[10], (L, MLA_KV_RANK)),
        'w_mla_ukv': dense(ks[11], (L, MLA_KV_RANK, MLA_HEADS * (MLA_NOPE + MLA_VD)), MLA_KV_RANK),
        'b_branch_gate': bias(ks[12], (L, N_BRANCH * D), 0.1),
        'w_up_fox': dense(ks[13], (L, FOX_W, D), FOX_W),
        'w_up_gla': dense(ks[14], (L, GLA_V_W, D), GLA_V_W),
        'w_up_mla': dense(ks[15], (L, MLA_W, D), MLA_W),
        'w_out': dense(ks[16], (L, D, D), D),
        'g_xa': gain(ks[17], (L, D)),
        'g_mem': gain(ks[18], (L, D)),
        'w_xq': dense(ks[19], (L, D, XA_W), D),
        'w_xkv': dense(ks[20], (L, D, 2 * XA_W), D),
        'w_xo': dense(ks[21], (L, XA_W, D), XA_W),
        'g_mlp': gain(ks[22], (L, D)),
        'w_mlp1': dense(ks[23], (L, D, D_FF), D),
        'w_mlp2': dense(ks[24], (L, D_FF, D), D_FF),
        'g_final': gain(ks[25], (D,)),
    }


def reference(x, mem, g_mix, w_in, b_fox_forget, w_gla_gate, b_gla_gate, g_gla_out,
              g_mla_q, w_mla_uq, g_mla_kv, w_mla_ukv, b_branch_gate,
              w_up_fox, w_up_gla, w_up_mla, w_out, g_xa, g_mem, w_xq, w_xkv, w_xo,
              g_mlp, w_mlp1, w_mlp2, g_final):
    b, s, d = x.shape
    pos = jnp.arange(s)
    for l in range(DEPTH):
        h = rms_norm(x, g_mix[l])
        z = h @ w_in[l]
        (fq, fk, fv, ff, gq, gk, gv, glow, gr, mq, mkv, mkr, zg) = split_cols(z, IN_SIZES)
        o_fox = fox_branch(fq, fk, fv, ff, b_fox_forget[l])
        o_gla = gla_branch(gq, gk, gv, glow, gr, w_gla_gate[l], b_gla_gate[l], g_gla_out[l])
        o_mla = mla_branch(mq, mkv, mkr, g_mla_q[l], w_mla_uq[l], g_mla_kv[l], w_mla_ukv[l], pos)
        gates = jax.nn.sigmoid((zg + b_branch_gate[l]).astype(F32)).astype(x.dtype)
        gates = gates.reshape(b, s, N_BRANCH, d)
        y = (gates[:, :, 0] * (o_fox @ w_up_fox[l])
             + gates[:, :, 1] * (o_gla @ w_up_gla[l])
             + gates[:, :, 2] * (o_mla @ w_up_mla[l]))
        x = x + y @ w_out[l]
        x = x + memory_cross_attention(rms_norm(x, g_xa[l]), rms_norm(mem, g_mem[l]),
                                       w_xq[l], w_xkv[l], w_xo[l])
        hm = rms_norm(x, g_mlp[l])
        x = x + jnp.square(jax.nn.relu(hm @ w_mlp1[l])) @ w_mlp2[l]
    return rms_norm(x, g_final)
```

```cpp
#include <hip/hip_runtime.h>
#include <hip/hip_cooperative_groups.h>
#include <cstdio>
#include <cstdint>
namespace cg = cooperative_groups;

#define LAS __attribute__((address_space(3)))
typedef unsigned short bf16_t;
typedef short bf16x8 __attribute__((ext_vector_type(8)));
typedef float f32x4 __attribute__((ext_vector_type(4)));
typedef float f32x2 __attribute__((ext_vector_type(2)));
typedef float f32x16 __attribute__((ext_vector_type(16)));
typedef unsigned u32x4 __attribute__((ext_vector_type(4)));
typedef unsigned u32x2 __attribute__((ext_vector_type(2)));
typedef __bf16 bf16x2n __attribute__((ext_vector_type(2)));

#define DI __device__ __forceinline__
DI unsigned pk2(float lo, float hi) { f32x2 f = {lo, hi}; bf16x2n b = __builtin_convertvector(f, bf16x2n); return __builtin_bit_cast(unsigned, b); }
DI float bf2f(unsigned short b) { return __uint_as_float(((unsigned)b) << 16); }
DI float bflo(unsigned w) { return __uint_as_float(w << 16); }
DI float bfhi(unsigned w) { return __uint_as_float(w & 0xffff0000u); }
DI void st4(bf16_t* p, f32x4 v) { u32x2 w; w.x = pk2(v[0], v[1]); w.y = pk2(v[2], v[3]); *(u32x2*)p = w; }
DI bf16x8 pack8(float a0, float a1, float a2, float a3, float a4, float a5, float a6, float a7) {
    u32x4 w; w.x = pk2(a0, a1); w.y = pk2(a2, a3); w.z = pk2(a4, a5); w.w = pk2(a6, a7); return __builtin_bit_cast(bf16x8, w);
}
#define MFMA32(a, b, c) __builtin_amdgcn_mfma_f32_32x32x16_bf16((a), (b), (c), 0, 0, 0)
DI int crow(int r, int hi) { return (r & 3) + 8 * (r >> 2) + 4 * hi; }

constexpr int T_TOK = 32768, SEQ = 4096, NBATCH = 8, DM = 1024, MEMLEN = 256;
constexpr int ZP = 2816;
constexpr int ZC_FQ = 0, ZC_FK = 256, ZC_FV = 512, ZC_GQ = 768, ZC_GK = 1024, ZC_GV = 1280, ZC_GR = 1792, ZC_MQ = 2304, ZC_MKV = 2560, ZC_MKR = 2688, ZC_FF = 2720, ZC_GLOW = 2736;
constexpr float LOG2E = 1.4426950408889634f;
constexpr float QS_FOX = 0.125f * LOG2E;
constexpr float QS_MLA = 0.10206207261596575f * LOG2E;
constexpr float QS_XA = 0.08838834764831845f * LOG2E;
constexpr float EPS = 1e-6f;

DI float logsig(float x) { return fminf(x, 0.f) - __logf(1.f + __expf(-fabsf(x))); }
DI float sigmoidf_(float x) { return __builtin_amdgcn_rcpf(1.f + __expf(-x)); }
DI float siluf_(float x) { return x * __builtin_amdgcn_rcpf(1.f + __expf(-x)); }
DI void rope_cs(int pos, int i, float& c, float& s) {
    const float inv = exp2f((float)i * (-13.287712379549449f / 16.0f));
    const float ang = (float)pos * inv;
    double rev = (double)ang * 0.15915494309189535;
    rev -= __builtin_rint(rev);
    const float rf = (float)rev;
    s = __builtin_amdgcn_sinf(rf); c = __builtin_amdgcn_cosf(rf);
}

namespace pg8 {
#define PG8_LAS __attribute__((address_space(3)))
constexpr int BM = 256, BK = 64, HALF = 128, HTB = HALF * BK * 2  , STAGE_BYTES = 8 * HTB, NXCD = 8, WGM = 8;
__host__ __device__ __forceinline__ int lds_byte(int r, int c) { const int st = (r >> 4) * 2 + (c >> 5), rr = r & 15, cc = c & 31, ob = rr * 64 + cc * 2; return st * 1024 + (ob ^ (((ob >> 9) & 1) << 5)); }
__host__ __device__ __forceinline__ void stage_rc(int b, int& R, int& C) { const int st = b / 1024, sb = b % 1024, swz = sb ^ (((sb >> 9) & 1) << 5); R = (st >> 1) * 16 + swz / 64; C = (st & 1) * 32 + (swz % 64) / 2; }
__host__ __device__ __forceinline__ int perm32(int rho) { const int n = rho >> 4, i = rho & 15; return 8 * (i >> 2) + 4 * n + (i & 3); }
struct Unit { int pm, pn; };
struct Gemm { const bf16_t* A; const bf16_t* Bt; int M, N, K, lda; };
struct StaticOrder {
    int nM, nN, nwg, G, c;
    __host__ __device__ void init(int M, int N, int G_, int c_) { nM = M / BM; nN = N / BM; nwg = nM * nN; G = G_; c = c_; }
    __host__ __device__ bool next(int i, Unit& u) const {
        const long L = (long)i * G + c; if (L >= nwg) return false;
        int wgid = (int)L; { const int q = nwg / NXCD, r = nwg % NXCD, xcd = wgid % NXCD, off = wgid / NXCD; wgid = (xcd < r ? xcd * (q + 1) : r * (q + 1) + (xcd - r) * q) + off; }
        const int nig = WGM * nN, gid = wgid / nig, fm = gid * WGM, gsz = (nM - fm) < WGM ? (nM - fm) : WGM;
        u.pm = fm + ((wgid % nig) % gsz); u.pn = (wgid % nig) / gsz; return true;
    }
    __device__ __forceinline__ void a_ready(const Unit&) const {}
    __device__ __forceinline__ void done(const Unit&) const {}
};
template <class Epi, class Sched, bool ALIGN_EPI = false, bool SP2 = false>
__device__ __forceinline__ void gemm_phase(PG8_LAS unsigned char* lds, const Gemm g, const Sched& S, const Epi& E) {
    int tid = threadIdx.x; asm volatile("" : "+v"(tid)); const int wid = __builtin_amdgcn_readfirstlane(tid >> 6), lane = tid & 63, wr = wid >> 2, wc = wid & 3, fr = lane & 15, fq = lane >> 4;
    const int K = g.K, nt = K / BK;
    unsigned voffA[2], voffB[2];
#pragma unroll
    for (int i = 0; i < 2; ++i) { int R, C; stage_rc(tid * 16 + i * 8192, R, C); const int Rb = Epi::PERM ? ((R & ~31) + perm32(R & 31)) : R;
        voffA[i] = (unsigned)(R * g.lda + C) * 2u; voffB[i] = (unsigned)(Rb * K + C) * 2u; }
    const size_t kstep = (size_t)(BK * 2);
    const size_t hstepA = (size_t)HALF * g.lda * 2, hstepB = (size_t)HALF * K * 2;
    const size_t tstepA = 2 * hstepA, tstepB = 2 * hstepB;
    const unsigned ldsw = (unsigned)wid * 1024u;
    const int aoff = lds_byte(wr * 64 + fr, fq * 8), boff = lds_byte(wc * 32 + fr, fq * 8);
#define PG8_SA(b, h) (((b) * 2 + (h)) * HTB)
#define PG8_SB(b, h) ((4 + (b) * 2 + (h)) * HTB)
#define PG8_STAGE(bufoff, gbase, voff) do { _Pragma("unroll") for (int _i = 0; _i < 2; ++_i) \
        __builtin_amdgcn_global_load_lds((const unsigned*)((const char*)(gbase) + (voff)[_i]), (PG8_LAS unsigned*)(lds + (bufoff) + ldsw + _i * 8192), 16, 0, 0); } while (0)
#define PG8_LDA(dst, b, h) do { _Pragma("unroll") for (int m = 0; m < 4; ++m) _Pragma("unroll") for (int k = 0; k < 2; ++k) dst[m][k] = *(const PG8_LAS bf16x8*)(lds + PG8_SA(b, h) + aoff + m * 2048 + k * 1024); } while (0)
#define PG8_LDB(dst, b, h) do { _Pragma("unroll") for (int n = 0; n < 2; ++n) _Pragma("unroll") for (int k = 0; k < 2; ++k) dst[n][k] = *(const PG8_LAS bf16x8*)(lds + PG8_SB(b, h) + boff + n * 2048 + k * 1024); } while (0)
#define PG8_MMA(ai, bj, At, Bt) do { __builtin_amdgcn_s_setprio(1); _Pragma("unroll") for (int m = 0; m < 4; ++m) _Pragma("unroll") for (int n = 0; n < 2; ++n) _Pragma("unroll") for (int k = 0; k < 2; ++k) \
        acc[ai][bj][m][n] = __builtin_amdgcn_mfma_f32_16x16x32_bf16(Bt[n][k], At[m][k], acc[ai][bj][m][n], 0, 0, 0); __builtin_amdgcn_s_setprio(0); } while (0)
#define PG8_WAIT_V(n) asm volatile("s_waitcnt vmcnt(" #n ")" ::: "memory")
#define PG8_WAIT_L(n) asm volatile("s_waitcnt lgkmcnt(" #n ")" ::: "memory")
#define PG8_BAR __builtin_amdgcn_s_barrier()
#define PG8_SCHED __builtin_amdgcn_sched_barrier(0)
    Unit cur, nxt; int ui = 0;
    if (!S.next(0, cur)) return;
    f32x4 acc[2][2][4][2];
#pragma unroll
    for (int a = 0; a < 2; ++a)
#pragma unroll
        for (int b = 0; b < 2; ++b)
#pragma unroll
            for (int m = 0; m < 4; ++m)
#pragma unroll
                for (int n = 0; n < 2; ++n) acc[a][b][m][n] = (f32x4){0.f, 0.f, 0.f, 0.f};
    bf16x8 At[4][2], B0[2][2], B1[2][2];
    const char* cA = (const char*)g.A + (size_t)cur.pm * tstepA; const char* cB = (const char*)g.Bt + (size_t)cur.pn * tstepB;
    S.a_ready(cur);
    if constexpr (SP2) {
        PG8_STAGE(PG8_SB(0, 0), cB, voffB); PG8_STAGE(PG8_SB(0, 1), cB + hstepB, voffB); PG8_STAGE(PG8_SA(0, 0), cA, voffA); PG8_STAGE(PG8_SA(0, 1), cA + hstepA, voffA);
        if (wr == 1) PG8_BAR;
        PG8_WAIT_V(2); PG8_BAR;
        PG8_STAGE(PG8_SB(1, 0), cB + kstep, voffB); PG8_STAGE(PG8_SA(1, 0), cA + kstep, voffA); PG8_STAGE(PG8_SB(1, 1), cB + hstepB + kstep, voffB);
        PG8_WAIT_V(6); PG8_BAR;
    } else {
        PG8_STAGE(PG8_SB(0, 0), cB, voffB); PG8_STAGE(PG8_SA(0, 0), cA, voffA); PG8_STAGE(PG8_SB(0, 1), cB + hstepB, voffB); PG8_STAGE(PG8_SA(0, 1), cA + hstepA, voffA);
        if (wr == 1) PG8_BAR;
        PG8_WAIT_V(4); PG8_BAR;
        PG8_STAGE(PG8_SB(1, 0), cB + kstep, voffB); PG8_STAGE(PG8_SA(1, 0), cA + kstep, voffA); PG8_STAGE(PG8_SB(1, 1), cB + hstepB + kstep, voffB);
        PG8_WAIT_V(6); PG8_BAR;
    }
    for (;;) {
        const bool has_next = S.next(ui + 1, nxt);
        const char* nA = has_next ? (const char*)g.A + (size_t)nxt.pm * tstepA : cA; const char* nB = has_next ? (const char*)g.Bt + (size_t)nxt.pn * tstepB : cB;
        for (int t = 0; t < nt; t += 2) {
            const bool last = (t == nt - 2);
            const char* a1 = cA + (size_t)(t + 1) * kstep;
            const char* a2 = last ? nA : cA + (size_t)(t + 2) * kstep; const char* b2 = last ? nB : cB + (size_t)(t + 2) * kstep;
            const char* a3 = a2 + kstep; const char* b3 = b2 + kstep;
            if (last && has_next) S.a_ready(nxt);
            if constexpr (SP2) {
            PG8_LDB(B0, 0, 0); PG8_LDB(B1, 0, 1); PG8_SCHED; PG8_LDA(At, 0, 0); PG8_STAGE(PG8_SA(1, 1), a1 + hstepA, voffA);
            PG8_WAIT_V(8); PG8_WAIT_L(0); PG8_BAR; PG8_MMA(0, 0, At, B0); PG8_MMA(0, 1, At, B1); PG8_BAR; PG8_SCHED;
            PG8_LDA(At, 0, 1); PG8_STAGE(PG8_SB(0, 0), b2, voffB); PG8_STAGE(PG8_SB(0, 1), b2 + hstepB, voffB); PG8_STAGE(PG8_SA(0, 0), a2, voffA);
            PG8_WAIT_V(8); PG8_WAIT_L(0); PG8_BAR; PG8_MMA(1, 0, At, B0); PG8_MMA(1, 1, At, B1); PG8_BAR; PG8_SCHED;
            PG8_LDB(B0, 1, 0); PG8_LDB(B1, 1, 1); PG8_SCHED; PG8_LDA(At, 1, 0); PG8_STAGE(PG8_SA(0, 1), a2 + hstepA, voffA);
            PG8_WAIT_V(8); PG8_WAIT_L(0); PG8_BAR; PG8_MMA(0, 0, At, B0); PG8_MMA(0, 1, At, B1); PG8_BAR; PG8_SCHED;
            PG8_LDA(At, 1, 1); PG8_STAGE(PG8_SB(1, 0), b3, voffB); PG8_STAGE(PG8_SB(1, 1), b3 + hstepB, voffB); PG8_STAGE(PG8_SA(1, 0), a3, voffA);
            PG8_WAIT_V(8); PG8_WAIT_L(0); PG8_BAR; PG8_MMA(1, 0, At, B0); PG8_MMA(1, 1, At, B1); PG8_BAR; PG8_SCHED;
            } else {
            PG8_LDB(B0, 0, 0); PG8_SCHED; PG8_LDA(At, 0, 0); PG8_STAGE(PG8_SA(1, 1), a1 + hstepA, voffA);
            PG8_WAIT_L(8); PG8_BAR; PG8_WAIT_L(0); PG8_MMA(0, 0, At, B0); PG8_BAR; PG8_SCHED;
            PG8_LDB(B1, 0, 1); PG8_STAGE(PG8_SB(0, 0), b2, voffB);
            PG8_BAR; PG8_WAIT_L(0); PG8_MMA(0, 1, At, B1); PG8_BAR;
            PG8_LDA(At, 0, 1); PG8_STAGE(PG8_SA(0, 0), a2, voffA);
            PG8_BAR; PG8_WAIT_L(0); PG8_MMA(1, 0, At, B0); PG8_BAR; PG8_SCHED;
            PG8_STAGE(PG8_SB(0, 1), b2 + hstepB, voffB);
            PG8_WAIT_V(6); PG8_BAR; PG8_MMA(1, 1, At, B1); PG8_BAR;
            PG8_LDB(B0, 1, 0); PG8_SCHED; PG8_LDA(At, 1, 0); PG8_STAGE(PG8_SA(0, 1), a2 + hstepA, voffA);
            PG8_WAIT_L(8); PG8_BAR; PG8_WAIT_L(0); PG8_MMA(0, 0, At, B0); PG8_BAR; PG8_SCHED;
            PG8_LDB(B1, 1, 1); PG8_STAGE(PG8_SB(1, 0), b3, voffB);
            PG8_BAR; PG8_WAIT_L(0); PG8_MMA(0, 1, At, B1); PG8_BAR;
            PG8_LDA(At, 1, 1); PG8_STAGE(PG8_SA(1, 0), a3, voffA);
            PG8_BAR; PG8_WAIT_L(0); PG8_MMA(1, 0, At, B0); PG8_BAR; PG8_SCHED;
            PG8_STAGE(PG8_SB(1, 1), b3 + hstepB, voffB);
            PG8_WAIT_V(6); PG8_BAR; PG8_MMA(1, 1, At, B1); PG8_BAR;
            }
        }
        if constexpr (ALIGN_EPI) { if (wr == 0) PG8_BAR; }
        if constexpr (!Epi::AFTER_DRAIN) { E(acc, cur, wr, wc, fr, fq); S.done(cur); }
        if (!has_next) break;
#pragma unroll
        for (int a = 0; a < 2; ++a)
#pragma unroll
            for (int b = 0; b < 2; ++b)
#pragma unroll
                for (int m = 0; m < 4; ++m)
#pragma unroll
                    for (int n = 0; n < 2; ++n) acc[a][b][m][n] = (f32x4){0.f, 0.f, 0.f, 0.f};
        cur = nxt; cA = nA; cB = nB; ++ui;
        if constexpr (ALIGN_EPI) { if (wr == 1) PG8_BAR; }
    }
    PG8_WAIT_V(0);
    if constexpr (!ALIGN_EPI) { if (wr == 0) PG8_BAR; }
    PG8_BAR;
    if constexpr (Epi::AFTER_DRAIN) { E.fused(acc, cur, wr, wc, fr, fq, lds, wid, lane); S.done(cur); }
#undef PG8_SA
#undef PG8_SB
#undef PG8_STAGE
#undef PG8_LDA
#undef PG8_LDB
#undef PG8_MMA
#undef PG8_WAIT_V
#undef PG8_WAIT_L
#undef PG8_BAR
#undef PG8_SCHED
}
}

DI float rowstat16(const float* p) {
    const f32x4 a = *(const f32x4*)p, b = *(const f32x4*)(p + 4), c = *(const f32x4*)(p + 8), d = *(const f32x4*)(p + 12);
    return (((a[0] + a[1]) + (a[2] + a[3])) + ((b[0] + b[1]) + (b[2] + b[3]))) + (((c[0] + c[1]) + (c[2] + c[3])) + ((d[0] + d[1]) + (d[2] + d[3])));
}
#define EPI_FENCE() do { asm volatile("" ::: "memory"); __builtin_amdgcn_sched_barrier(0); } while (0)
DI void rope8(f32x4& v0, f32x4& v1, const int pos, const int fq) {
    float own[8] = {v0[0], v0[1], v0[2], v0[3], v1[0], v1[1], v1[2], v1[3]}, oth[8];
#pragma unroll
    for (int t = 0; t < 8; ++t) oth[t] = __shfl_xor(own[t], 32);
    const bool first = fq < 2; const int ib = 8 * (fq & 1);
#pragma unroll
    for (int t = 0; t < 8; ++t) { float c, s; rope_cs(pos, ib + t, c, s); own[t] = first ? (own[t] * c - oth[t] * s) : (own[t] * c + oth[t] * s); }
    v0 = (f32x4){own[0], own[1], own[2], own[3]}; v1 = (f32x4){own[4], own[5], own[6], own[7]};
}
DI void st8(bf16_t* p, const f32x4& v0, const f32x4& v1) { u32x4 w; w.x = pk2(v0[0], v0[1]); w.y = pk2(v0[2], v0[3]); w.z = pk2(v1[0], v1[1]); w.w = pk2(v1[2], v1[3]); *(u32x4*)p = w; }
struct EpiA {
    static constexpr bool PERM = true, AFTER_DRAIN = false;
    int mode;
    const bf16_t* xin_b; bf16_t* xout_b; float* ss_out;
    const float* rs_in;
    bf16_t* z; float* lf; float* ssq; const float* bfox;
    bf16_t* qh; bf16_t* kvb;
    __device__ __forceinline__ void operator()(const f32x4 (&acc)[2][2][4][2], const pg8::Unit& u, int wr, int wc, int fr, int fq) const {
        const int rbase = u.pm * 256 + wr * 64 + fr;
        const int colb = u.pn * 256 + wc * 32 + 8 * fq;
        if (mode == 0) {
#pragma unroll
            for (int ai = 0; ai < 2; ++ai) {
                u32x4 xo[4][2];
#pragma unroll
                for (int m = 0; m < 4; ++m)
#pragma unroll
                    for (int bj = 0; bj < 2; ++bj) xo[m][bj] = *(const u32x4*)(xin_b + (size_t)(rbase + ai * 128 + m * 16) * 1024 + colb + bj * 128);
                EPI_FENCE();
#pragma unroll
                for (int m = 0; m < 4; ++m) {
                    const int row = rbase + ai * 128 + m * 16;
                    float ss = 0.f;
#pragma unroll
                    for (int bj = 0; bj < 2; ++bj) {
                        const u32x4 x = xo[m][bj];
                        f32x4 v0 = acc[ai][bj][m][0], v1 = acc[ai][bj][m][1];
                        v0[0] += bflo(x.x); v0[1] += bfhi(x.x); v0[2] += bflo(x.y); v0[3] += bfhi(x.y); v1[0] += bflo(x.z); v1[1] += bfhi(x.z); v1[2] += bflo(x.w); v1[3] += bfhi(x.w);
                        u32x4 w; w.x = pk2(v0[0], v0[1]); w.y = pk2(v0[2], v0[3]); w.z = pk2(v1[0], v1[1]); w.w = pk2(v1[2], v1[3]);
                        *(u32x4*)(xout_b + (size_t)row * 1024 + colb + bj * 128) = w;
                        const float r0 = bflo(w.x), r1 = bfhi(w.x), r2 = bflo(w.y), r3 = bfhi(w.y), r4 = bflo(w.z), r5 = bfhi(w.z), r6 = bflo(w.w), r7 = bfhi(w.w);
                        ss += ((r0 * r0 + r1 * r1) + (r2 * r2 + r3 * r3)) + ((r4 * r4 + r5 * r5) + (r6 * r6 + r7 * r7));
                    }
                    ss += __shfl_xor(ss, 16); ss += __shfl_xor(ss, 32);
                    if (fq == 0) ss_out[(size_t)row * 16 + u.pn * 4 + wc] = ss;
                }
                EPI_FENCE();
            }
        } else if (mode == 1) {
            const int pn = u.pn;
#pragma unroll
            for (int ai = 0; ai < 2; ++ai) {
                float rs4[4];
#pragma unroll
                for (int m = 0; m < 4; ++m) rs4[m] = rsqrtf(rowstat16(rs_in + (size_t)(rbase + ai * 128 + m * 16) * 16) * (1.f / 1024.f) + EPS);
                EPI_FENCE();
                if (pn < 10) {
#pragma unroll
                    for (int m = 0; m < 4; ++m) {
                        const int row = rbase + ai * 128 + m * 16;
                        const float rs = rs4[m];
                        float ss = 0.f;
#pragma unroll
                        for (int bj = 0; bj < 2; ++bj) {
                            f32x4 v0 = acc[ai][bj][m][0] * rs, v1 = acc[ai][bj][m][1] * rs;
                            if (pn == 0) { v0 = v0 * QS_FOX; v1 = v1 * QS_FOX; }
                            else if (pn == 7 || pn == 8) {
#pragma unroll
                                for (int j = 0; j < 4; ++j) { v0[j] = siluf_(v0[j]); v1[j] = siluf_(v1[j]); }
                            } else if (pn == 9) ss += ((v0[0] * v0[0] + v0[1] * v0[1]) + (v0[2] * v0[2] + v0[3] * v0[3])) + ((v1[0] * v1[0] + v1[1] * v1[1]) + (v1[2] * v1[2] + v1[3] * v1[3]));
                            st8(z + (size_t)row * ZP + colb + bj * 128, v0, v1);
                        }
                        if (pn == 9) { ss += __shfl_xor(ss, 16); ss += __shfl_xor(ss, 32); if (fq == 0) ssq[(size_t)row * 8 + wc] = ss; }
                    }
                } else {
#pragma unroll
                    for (int m = 0; m < 4; ++m) {
                        const int row = rbase + ai * 128 + m * 16;
                        const int pos = row & (SEQ - 1);
                        bf16_t* zr = z + (size_t)row * ZP + 2560;
                        const float rs = rs4[m];
                        {
                            const f32x4 v0 = acc[ai][0][m][0] * rs, v1 = acc[ai][0][m][1] * rs;
                            float ss = ((v0[0] * v0[0] + v0[1] * v0[1]) + (v0[2] * v0[2] + v0[3] * v0[3])) + ((v1[0] * v1[0] + v1[1] * v1[1]) + (v1[2] * v1[2] + v1[3] * v1[3]));
                            st8(zr + wc * 32 + 8 * fq, v0, v1);
                            ss += __shfl_xor(ss, 16); ss += __shfl_xor(ss, 32);
                            if (fq == 0) ssq[(size_t)row * 8 + 4 + wc] = ss;
                        }
                        if (wc == 0) {
                            f32x4 v0 = acc[ai][1][m][0] * rs, v1 = acc[ai][1][m][1] * rs;
                            rope8(v0, v1, pos, fq);
                            st8(zr + 128 + 8 * fq, v0, v1);
                        } else if (wc == 1) {
                            if (fq == 0) { f32x4 v = acc[ai][1][m][0] * rs;
#pragma unroll
                                for (int j = 0; j < 4; ++j) v[j] = logsig(v[j] + bfox[j]) * LOG2E;
                                *(f32x4*)(lf + (size_t)row * 4) = v; }
                            if (fq >= 2) st8(zr + 160 + 8 * fq, acc[ai][1][m][0] * rs, acc[ai][1][m][1] * rs);
                        }
                        EPI_FENCE();
                    }
                }
                EPI_FENCE();
            }
        } else {
#pragma unroll
            for (int ai = 0; ai < 2; ++ai) {
                float rq4[4], rkv4[4];
#pragma unroll
                for (int m = 0; m < 4; ++m) {
                    const float* sp = ssq + (size_t)(rbase + ai * 128 + m * 16) * 8;
                    const f32x4 pq = *(const f32x4*)sp, pk = *(const f32x4*)(sp + 4);
                    rq4[m] = rsqrtf(((pq[0] + pq[1]) + (pq[2] + pq[3])) * (1.f / 256.f) + EPS) * QS_MLA;
                    rkv4[m] = rsqrtf(((pk[0] + pk[1]) + (pk[2] + pk[3])) * (1.f / 128.f) + EPS);
                }
                EPI_FENCE();
#pragma unroll
                for (int m = 0; m < 4; ++m) {
                    const int row = rbase + ai * 128 + m * 16;
                    const int pos = row & (SEQ - 1);
                    const float rq = rq4[m], rkv = rkv4[m];
#pragma unroll
                    for (int bj = 0; bj < 2; ++bj) {
                        const int G = u.pn * 8 + bj * 4 + wc;
                        if (G < 12) {
                            const int head = G / 3, part = G - 3 * head;
                            f32x4 v0 = acc[ai][bj][m][0] * rq, v1 = acc[ai][bj][m][1] * rq;
                            if (part == 2) rope8(v0, v1, pos, fq);
                            st8(qh + (size_t)row * 384 + head * 96 + part * 32 + 8 * fq, v0, v1);
                        } else if (G < 28) {
                            st8(kvb + (size_t)row * 512 + (G - 12) * 32 + 8 * fq, acc[ai][bj][m][0] * rkv, acc[ai][bj][m][1] * rkv);
                        }
                    }
                    EPI_FENCE();
                }
            }
        }
    }
};
struct EpiB {
    static constexpr bool PERM = true, AFTER_DRAIN = false;
    int mode; bf16_t* out; int ldc; float scale; const float* bias; const bf16_t* gate; int first; const float* rs_in;
    __device__ __forceinline__ void operator()(const f32x4 (&acc)[2][2][4][2], const pg8::Unit& u, int wr, int wc, int fr, int fq) const {
        const int rbase = u.pm * 256 + wr * 64 + fr;
        const int colb = u.pn * 256 + wc * 32 + 8 * fq;
        if (mode == 3) {
#pragma unroll
            for (int ai = 0; ai < 2; ++ai) {
                u32x4 g4[4][2], y4[4][2];
#pragma unroll
                for (int m = 0; m < 4; ++m)
#pragma unroll
                    for (int bj = 0; bj < 2; ++bj) {
                        const size_t off = (size_t)(rbase + ai * 128 + m * 16) * ldc + colb + bj * 128;
                        g4[m][bj] = *(const u32x4*)(gate + off);
                        if (!first) y4[m][bj] = *(const u32x4*)(out + off); else y4[m][bj] = (u32x4){0u, 0u, 0u, 0u};
                    }
                EPI_FENCE();
#pragma unroll
                for (int m = 0; m < 4; ++m)
#pragma unroll
                    for (int bj = 0; bj < 2; ++bj) {
                        const size_t off = (size_t)(rbase + ai * 128 + m * 16) * ldc + colb + bj * 128;
                        const u32x4 g = g4[m][bj], y = y4[m][bj];
                        f32x4 v0 = acc[ai][bj][m][0], v1 = acc[ai][bj][m][1];
                        v0[0] = v0[0] * bflo(g.x) + bflo(y.x); v0[1] = v0[1] * bfhi(g.x) + bfhi(y.x); v0[2] = v0[2] * bflo(g.y) + bflo(y.y); v0[3] = v0[3] * bfhi(g.y) + bfhi(y.y);
                        v1[0] = v1[0] * bflo(g.z) + bflo(y.z); v1[1] = v1[1] * bfhi(g.z) + bfhi(y.z); v1[2] = v1[2] * bflo(g.w) + bflo(y.w); v1[3] = v1[3] * bfhi(g.w) + bfhi(y.w);
                        u32x4 w; w.x = pk2(v0[0], v0[1]); w.y = pk2(v0[2], v0[3]); w.z = pk2(v1[0], v1[1]); w.w = pk2(v1[2], v1[3]);
                        *(u32x4*)(out + off) = w;
                    }
                EPI_FENCE();
            }
            return;
        }
#pragma unroll
        for (int ai = 0; ai < 2; ++ai) {
            float rs4[4];
#pragma unroll
            for (int m = 0; m < 4; ++m) rs4[m] = rs_in ? rsqrtf(rowstat16(rs_in + (size_t)(rbase + ai * 128 + m * 16) * 16) * (1.f / 1024.f) + EPS) : 1.f;
            EPI_FENCE();
#pragma unroll
            for (int m = 0; m < 4; ++m) {
                const int row = rbase + ai * 128 + m * 16;
                const float rs = rs4[m];
#pragma unroll
                for (int bj = 0; bj < 2; ++bj) {
                    const int col = colb + bj * 128;
                    const size_t off = (size_t)row * ldc + col;
                    f32x4 v0 = acc[ai][bj][m][0] * rs, v1 = acc[ai][bj][m][1] * rs;
                    if (mode == 0) { v0 = v0 * scale; v1 = v1 * scale; }
                    else if (mode == 1) {
#pragma unroll
                        for (int j = 0; j < 4; ++j) { const float a = fmaxf(v0[j], 0.f), b = fmaxf(v1[j], 0.f); v0[j] = a * a; v1[j] = b * b; }
                    } else {
                        const f32x4 b0 = *(const f32x4*)(bias + col), b1 = *(const f32x4*)(bias + col + 4);
#pragma unroll
                        for (int j = 0; j < 4; ++j) { v0[j] = sigmoidf_(v0[j] + b0[j]); v1[j] = sigmoidf_(v1[j] + b1[j]); }
                    }
                    u32x4 w; w.x = pk2(v0[0], v0[1]); w.y = pk2(v0[2], v0[3]); w.z = pk2(v1[0], v1[1]); w.w = pk2(v1[2], v1[3]);
                    *(u32x4*)(out + off) = w;
                }
            }
            EPI_FENCE();
        }
    }
};

template <class Epi>
DI void run_gemm(LAS unsigned char* lds, const bf16_t* A, int lda, const bf16_t* Bt, int M, int N, int K, const Epi& E, int cshift) {
    pg8::Gemm g; g.A = A; g.Bt = Bt; g.M = M; g.N = N; g.K = K; g.lda = lda;
    pg8::StaticOrder so; so.init(M, N, (int)gridDim.x, (int)((blockIdx.x + cshift) % gridDim.x));
    pg8::gemm_phase<Epi, pg8::StaticOrder, true, true>(lds, g, so, E);
}

struct AttnP {
    const bf16_t* q; int qp;
    const bf16_t* k1; int k1p; const bf16_t* k2; int k2p;
    const bf16_t* v; int vp;
    bf16_t* o; int op;
    const float* bias;
    float kmax;
};
#define ATT_BAR() do { asm volatile("s_waitcnt lgkmcnt(0)" ::: "memory"); __builtin_amdgcn_s_barrier(); asm volatile("" ::: "memory"); } while (0)
template <int DK, int DV, int MODE, int VP = 68>
DI void attn_tile(const LAS unsigned char* kbuf, const LAS unsigned char* vbuf, const LAS float* cb, const int j, const int q0w, const int qrow, const int l32, const int hi, const float cq,
                  const bf16x8 (&qf)[DK / 16], f32x16 (&o)[DV / 32], float& mrun, float& lrun) {
    constexpr int KP = DK + 8;
    f32x16 s0, s1;
#pragma unroll
    for (int r = 0; r < 16; ++r) { s0[r] = 0.f; s1[r] = 0.f; }
    const LAS unsigned char* kb = kbuf + (l32 * KP + 8 * hi) * 2;
    const LAS unsigned char* vb = vbuf + (l32 * VP + 4 * hi) * 2;
    constexpr int KCHK = 2;
#pragma unroll
    for (int c0 = 0; c0 < DK / 16; c0 += KCHK) {
        bf16x8 ka[2][KCHK];
#pragma unroll
        for (int ds = 0; ds < KCHK; ++ds) { ka[0][ds] = *(const LAS bf16x8*)(kb + (c0 + ds) * 32); ka[1][ds] = *(const LAS bf16x8*)(kb + 32 * KP * 2 + (c0 + ds) * 32); }
#pragma unroll
        for (int ds = 0; ds < KCHK; ++ds) { s0 = MFMA32(ka[0][ds], qf[c0 + ds], s0); s1 = MFMA32(ka[1][ds], qf[c0 + ds], s1); }
    }
    if (MODE == 0) {
#pragma unroll
        for (int rq = 0; rq < 4; ++rq) {
            const f32x4 c0 = *(const LAS f32x4*)(cb + 8 * rq + 4 * hi), c1 = *(const LAS f32x4*)(cb + 32 + 8 * rq + 4 * hi);
#pragma unroll
            for (int jj = 0; jj < 4; ++jj) { s0[4 * rq + jj] += cq - c0[jj]; s1[4 * rq + jj] += cq - c1[jj]; }
        }
        if (64 * j + 63 > q0w) {
#pragma unroll
            for (int r = 0; r < 16; ++r) { const int kv = 64 * j + crow(r, hi); if (kv > qrow) s0[r] = -__builtin_inff(); if (kv + 32 > qrow) s1[r] = -__builtin_inff(); }
        }
    }
    float mx = fmaxf(s0[0], s1[0]);
#pragma unroll
    for (int r = 1; r < 16; ++r) mx = fmaxf(mx, fmaxf(s0[r], s1[r]));
    mx = fmaxf(mx, __shfl_xor(mx, 32));
    const float mn = fmaxf(mrun, mx);
    const float alpha = __builtin_amdgcn_exp2f(mrun - mn);
    mrun = mn;
    float ls = 0.f;
#pragma unroll
    for (int r = 0; r < 16; ++r) { s0[r] = __builtin_amdgcn_exp2f(s0[r] - mn); s1[r] = __builtin_amdgcn_exp2f(s1[r] - mn); ls += s0[r] + s1[r]; }
    lrun = lrun * alpha + ls;
#pragma unroll
    for (int i = 0; i < DV / 32; ++i)
#pragma unroll
        for (int r = 0; r < 16; ++r) o[i][r] *= alpha;
    bf16x8 pf[4];
    pf[0] = pack8(s0[0], s0[1], s0[2], s0[3], s0[4], s0[5], s0[6], s0[7]);
    pf[1] = pack8(s0[8], s0[9], s0[10], s0[11], s0[12], s0[13], s0[14], s0[15]);
    pf[2] = pack8(s1[0], s1[1], s1[2], s1[3], s1[4], s1[5], s1[6], s1[7]);
    pf[3] = pack8(s1[8], s1[9], s1[10], s1[11], s1[12], s1[13], s1[14], s1[15]);
#pragma unroll
    for (int dvp = 0; dvp < DV / 32; ++dvp) {
        u32x2 wlo[4], whi[4];
#pragma unroll
        for (int f = 0; f < 4; ++f) {
            const int off = dvp * 32 * VP * 2 + (32 * (f >> 1) + 16 * (f & 1)) * 2;
            wlo[f] = *(const LAS u32x2*)(vb + off); whi[f] = *(const LAS u32x2*)(vb + off + 16);
        }
#pragma unroll
        for (int f = 0; f < 4; ++f) {
            u32x4 av; av.x = wlo[f].x; av.y = wlo[f].y; av.z = whi[f].x; av.w = whi[f].y;
            o[dvp] = MFMA32(__builtin_bit_cast(bf16x8, av), pf[f], o[dvp]);
        }
    }
}

template <int DK, int DV, int MODE, int K1C>
DI void attn_unit(LAS unsigned char* lds, const AttnP& a, const int q0, const int tid_in) {
    int tid = tid_in; asm volatile("" : "+v"(tid));
    constexpr int KP = DK + 8, VP = 68;
    constexpr int KBYTES = 64 * KP * 2, VBYTES = DV * VP * 2;
    constexpr int KCH = DK / 8, NKC = 64 * KCH, KPT = (NKC + 511) / 512;
    constexpr int VCH = DV / 8, NVT = 32 * VCH;
    LAS unsigned char* Kb = lds; LAS unsigned char* Vb = lds + 2 * KBYTES; LAS float* Cb = (LAS float*)(lds + 2 * KBYTES + 2 * VBYTES);
    const int wave = tid >> 6, lane = tid & 63, l32 = lane & 31, hi = lane >> 5;
    const int q0w = q0 + 32 * wave, qrow = q0w + l32;
    int ntiles, wtiles;
    if (MODE == 2) { ntiles = 4; wtiles = 4; }
    else { ntiles = (q0 + 256) / 64; wtiles = (MODE == 0) ? ((q0w + 31) / 64 + 1) : (q0w / 64 + 1); }
    bf16x8 qf[DK / 16];
#pragma unroll
    for (int ds = 0; ds < DK / 16; ++ds) qf[ds] = *(const bf16x8*)(a.q + (size_t)qrow * a.qp + ds * 16 + 8 * hi);
    float cq = 0.f; if (MODE == 0) cq = a.bias[qrow];
    f32x16 o[DV / 32];
#pragma unroll
    for (int i = 0; i < DV / 32; ++i)
#pragma unroll
        for (int r = 0; r < 16; ++r) o[i][r] = 0.f;
    float mrun = -__builtin_inff(), lrun = 0.f;
    u32x4 krA[KPT], krB[KPT]; u32x4 vrA0 = {0, 0, 0, 0}, vrA1 = {0, 0, 0, 0}, vrB0 = {0, 0, 0, 0}, vrB1 = {0, 0, 0, 0}; float crA = 0.f, crB = 0.f;
    const int vkvp = tid / VCH, vdvg = tid % VCH;
#define ATT_GLOAD(S, J) do { \
        _Pragma("unroll") for (int p_ = 0; p_ < KPT; ++p_) { const int ci_ = tid + 512 * p_; if (ci_ < NKC) { const int row_ = ci_ / KCH, cc_ = ci_ % KCH; \
            const bf16_t* src_ = (cc_ < K1C) ? (a.k1 + (size_t)(64 * (J) + row_) * a.k1p + cc_ * 8) : (a.k2 + (size_t)(64 * (J) + row_) * a.k2p + (cc_ - K1C) * 8); \
            kr##S[p_] = *(const u32x4*)src_; } } \
        if (tid < NVT) { const bf16_t* vs_ = a.v + (size_t)(64 * (J) + 2 * vkvp) * a.vp + vdvg * 8; vr##S##0 = *(const u32x4*)vs_; vr##S##1 = *(const u32x4*)(vs_ + a.vp); } \
        if (MODE == 0 && tid < 64) cr##S = a.bias[64 * (J) + tid]; } while (0)
#define ATT_LWRITE(S, B) do { \
        _Pragma("unroll") for (int p_ = 0; p_ < KPT; ++p_) { const int ci_ = tid + 512 * p_; if (ci_ < NKC) { const int row_ = ci_ / KCH, cc_ = ci_ % KCH; \
            *(LAS u32x4*)(Kb + (B) * KBYTES + (row_ * KP + cc_ * 8) * 2) = kr##S[p_]; } } \
        if (tid < NVT) { LAS unsigned char* vd_ = Vb + (B) * VBYTES + ((vdvg * 8) * VP + 2 * vkvp) * 2; \
            _Pragma("unroll") for (int w_ = 0; w_ < 4; ++w_) { \
                *(LAS unsigned*)(vd_ + (2 * w_) * VP * 2) = (vr##S##0[w_] & 0xffffu) | (vr##S##1[w_] << 16); \
                *(LAS unsigned*)(vd_ + (2 * w_ + 1) * VP * 2) = (vr##S##0[w_] >> 16) | (vr##S##1[w_] & 0xffff0000u); } } \
        if (MODE == 0 && tid < 64) Cb[(B) * 64 + tid] = cr##S; } while (0)
    ATT_GLOAD(A, 0);
    ATT_GLOAD(B, 1);
    ATT_LWRITE(A, 0);
    ATT_GLOAD(A, 2);
    for (int j = 0; j < ntiles; j += 2) {
        __syncthreads();
        if (j < wtiles) attn_tile<DK, DV, MODE>(Kb, Vb, Cb, j, q0w, qrow, l32, hi, cq, qf, o, mrun, lrun);
        ATT_LWRITE(B, 1);
        if (j + 3 < ntiles) ATT_GLOAD(B, j + 3);
        __syncthreads();
        if (j + 1 < wtiles) attn_tile<DK, DV, MODE>(Kb + KBYTES, Vb + VBYTES, Cb + 64, j + 1, q0w, qrow, l32, hi, cq, qf, o, mrun, lrun);
        if (j + 2 < ntiles) { ATT_LWRITE(A, 0); if (j + 4 < ntiles) ATT_GLOAD(A, j + 4); }
    }
    __syncthreads();
#undef ATT_GLOAD
#undef ATT_LWRITE
    const float lt = lrun + __shfl_xor(lrun, 32);
    const float inv = 1.0f / lt;
    bf16_t* orow = a.o + (size_t)qrow * a.op + 4 * hi;
#pragma unroll
    for (int dvh = 0; dvh < DV / 32; ++dvh)
#pragma unroll
        for (int rq = 0; rq < 4; ++rq) {
            f32x4 v; v[0] = o[dvh][4 * rq] * inv; v[1] = o[dvh][4 * rq + 1] * inv; v[2] = o[dvh][4 * rq + 2] * inv; v[3] = o[dvh][4 * rq + 3] * inv;
            st4(orow + dvh * 32 + 8 * rq, v);
        }
}

template <int DK>
DI void attn_qk(const LAS unsigned char* kbuf, const int l32, const int hi, const bf16x8 (&qf)[DK / 16], f32x16& s0, f32x16& s1) {
    constexpr int KP = DK + 8;
#pragma unroll
    for (int r = 0; r < 16; ++r) { s0[r] = 0.f; s1[r] = 0.f; }
    const LAS unsigned char* kb = kbuf + (l32 * KP + 8 * hi) * 2;
#pragma unroll
    for (int c0 = 0; c0 < DK / 16; c0 += 2) {
        bf16x8 ka[2][2];
#pragma unroll
        for (int ds = 0; ds < 2; ++ds) { ka[0][ds] = *(const LAS bf16x8*)(kb + (c0 + ds) * 32); ka[1][ds] = *(const LAS bf16x8*)(kb + 32 * KP * 2 + (c0 + ds) * 32); }
#pragma unroll
        for (int ds = 0; ds < 2; ++ds) { s0 = MFMA32(ka[0][ds], qf[c0 + ds], s0); s1 = MFMA32(ka[1][ds], qf[c0 + ds], s1); }
    }
}
template <int DV, int MODE>
DI void attn_sm_pv(f32x16& s0, f32x16& s1, const LAS unsigned char* vbuf, const LAS float* cb, const int j, const int q0w, const int qrow, const int l32, const int hi,
                   f32x16 (&o)[DV / 32], float& mrun, float& lrun) {
    constexpr int VP = 68;
    const LAS unsigned char* vb = vbuf + (l32 * VP + 4 * hi) * 2;
    if (MODE == 0) {
#pragma unroll
        for (int rq = 0; rq < 4; ++rq) {
            const f32x4 c0 = *(const LAS f32x4*)(cb + 8 * rq + 4 * hi), c1 = *(const LAS f32x4*)(cb + 32 + 8 * rq + 4 * hi);
#pragma unroll
            for (int jj = 0; jj < 4; ++jj) { s0[4 * rq + jj] -= c0[jj]; s1[4 * rq + jj] -= c1[jj]; }
        }
        if (64 * j + 63 > q0w) {
#pragma unroll
            for (int r = 0; r < 16; ++r) { const int kv = 64 * j + crow(r, hi); if (kv > qrow) s0[r] = -__builtin_inff(); if (kv + 32 > qrow) s1[r] = -__builtin_inff(); }
        }
    }
    float mx = fmaxf(s0[0], s1[0]);
#pragma unroll
    for (int r = 1; r < 16; ++r) mx = fmaxf(mx, fmaxf(s0[r], s1[r]));
    mx = fmaxf(mx, __shfl_xor(mx, 32));
    const float mn = fmaxf(mrun, mx);
    const float alpha = __builtin_amdgcn_exp2f(mrun - mn);
    mrun = mn;
    float ls = 0.f;
#pragma unroll
    for (int r = 0; r < 16; ++r) { s0[r] = __builtin_amdgcn_exp2f(s0[r] - mn); s1[r] = __builtin_amdgcn_exp2f(s1[r] - mn); ls += s0[r] + s1[r]; }
    lrun = lrun * alpha + ls;
#pragma unroll
    for (int i = 0; i < DV / 32; ++i)
#pragma unroll
        for (int r = 0; r < 16; ++r) o[i][r] *= alpha;
    bf16x8 pf[4];
    pf[0] = pack8(s0[0], s0[1], s0[2], s0[3], s0[4], s0[5], s0[6], s0[7]);
    pf[1] = pack8(s0[8], s0[9], s0[10], s0[11], s0[12], s0[13], s0[14], s0[15]);
    pf[2] = pack8(s1[0], s1[1], s1[2], s1[3], s1[4], s1[5], s1[6], s1[7]);
    pf[3] = pack8(s1[8], s1[9], s1[10], s1[11], s1[12], s1[13], s1[14], s1[15]);
#pragma unroll
    for (int dvp = 0; dvp < DV / 32; dvp += 2) {
        u32x2 wlo[2][4], whi[2][4];
#pragma unroll
        for (int d2 = 0; d2 < 2; ++d2)
#pragma unroll
            for (int f = 0; f < 4; ++f) {
                const int off = (dvp + d2) * 32 * VP * 2 + (32 * (f >> 1) + 16 * (f & 1)) * 2;
                wlo[d2][f] = *(const LAS u32x2*)(vb + off); whi[d2][f] = *(const LAS u32x2*)(vb + off + 16);
            }
#pragma unroll
        for (int d2 = 0; d2 < 2; ++d2)
#pragma unroll
            for (int f = 0; f < 4; ++f) {
                u32x4 av; av.x = wlo[d2][f].x; av.y = wlo[d2][f].y; av.z = whi[d2][f].x; av.w = whi[d2][f].y;
                o[dvp + d2] = MFMA32(__builtin_bit_cast(bf16x8, av), pf[f], o[dvp + d2]);
            }
    }
}
template <int DK, int DV, int MODE, int K1C>
DI void attn_unit_p(LAS unsigned char* lds, const AttnP& a, const int q0, const int tid_in) {
    int tid = tid_in; asm volatile("" : "+v"(tid));
    constexpr int KP = DK + 8, VP = 68;
    constexpr int KBYTES = 64 * KP * 2, VBYTES = DV * VP * 2;
    constexpr int KCH = DK / 8, NKC = 64 * KCH, KPT = (NKC + 511) / 512;
    constexpr int VCH = DV / 8, NVT = 32 * VCH;
    LAS unsigned char* Kb = lds; LAS unsigned char* Vb = lds + 2 * KBYTES; LAS float* Cb = (LAS float*)(lds + 2 * KBYTES + 2 * VBYTES);
    const int wave = tid >> 6, lane = tid & 63, l32 = lane & 31, hi = lane >> 5;
    const int q0w = q0 + 32 * wave, qrow = q0w + l32;
    const int ntiles = (q0 + 256) / 64;
    const int wtiles = (MODE == 0) ? ((q0w + 31) / 64 + 1) : (q0w / 64 + 1);
    bf16x8 qf[DK / 16];
#pragma unroll
    for (int ds = 0; ds < DK / 16; ++ds) qf[ds] = *(const bf16x8*)(a.q + (size_t)qrow * a.qp + ds * 16 + 8 * hi);
    f32x16 o[DV / 32];
#pragma unroll
    for (int i = 0; i < DV / 32; ++i)
#pragma unroll
        for (int r = 0; r < 16; ++r) o[i][r] = 0.f;
    float mrun = -__builtin_inff(), lrun = 0.f;
    u32x4 krA[KPT], krB[KPT]; u32x4 vrA0 = {0, 0, 0, 0}, vrA1 = {0, 0, 0, 0}, vrB0 = {0, 0, 0, 0}, vrB1 = {0, 0, 0, 0}; float crA = 0.f, crB = 0.f;
    const int vkvp = tid / VCH, vdvg = tid % VCH;
#define ATP_GLOADK(S, J) do { if ((J) < ntiles) { \
        _Pragma("unroll") for (int p_ = 0; p_ < KPT; ++p_) { const int ci_ = tid + 512 * p_; if (ci_ < NKC) { const int row_ = ci_ / KCH, cc_ = ci_ % KCH; \
            const bf16_t* src_ = (cc_ < K1C) ? (a.k1 + (size_t)(64 * (J) + row_) * a.k1p + cc_ * 8) : (a.k2 + (size_t)(64 * (J) + row_) * a.k2p + (cc_ - K1C) * 8); \
            kr##S[p_] = *(const u32x4*)src_; } } } } while (0)
#define ATP_GLOADV(S, J) do { if ((J) < ntiles) { \
        if (tid < NVT) { const bf16_t* vs_ = a.v + (size_t)(64 * (J) + 2 * vkvp) * a.vp + vdvg * 8; vr##S##0 = *(const u32x4*)vs_; vr##S##1 = *(const u32x4*)(vs_ + a.vp); } \
        if (MODE == 0 && tid < 64) cr##S = a.bias[64 * (J) + tid]; } } while (0)
#define ATP_LWRITEK(S, B, J) do { if ((J) < ntiles) { \
        _Pragma("unroll") for (int p_ = 0; p_ < KPT; ++p_) { const int ci_ = tid + 512 * p_; if (ci_ < NKC) { const int row_ = ci_ / KCH, cc_ = ci_ % KCH; \
            *(LAS u32x4*)(Kb + (B) * KBYTES + (row_ * KP + cc_ * 8) * 2) = kr##S[p_]; } } } } while (0)
#define ATP_LWRITEV(S, B, J) do { if ((J) < ntiles) { \
        if (tid < NVT) { LAS unsigned char* vd_ = Vb + (B) * VBYTES + ((vdvg * 8) * VP + 2 * vkvp) * 2; \
            _Pragma("unroll") for (int w_ = 0; w_ < 4; ++w_) { \
                *(LAS unsigned*)(vd_ + (2 * w_) * VP * 2) = (vr##S##0[w_] & 0xffffu) | (vr##S##1[w_] << 16); \
                *(LAS unsigned*)(vd_ + (2 * w_ + 1) * VP * 2) = (vr##S##0[w_] >> 16) | (vr##S##1[w_] & 0xffff0000u); } } \
        if (MODE == 0 && tid < 64) Cb[(B) * 64 + tid] = cr##S; } } while (0)
    ATP_GLOADK(A, 0); ATP_GLOADV(A, 0); ATP_GLOADK(B, 1); ATP_GLOADV(B, 1);
    ATP_LWRITEK(A, 0, 0); ATP_LWRITEV(A, 0, 0);
    ATP_GLOADK(A, 2); ATP_GLOADV(A, 2);
    ATT_BAR();
    f32x16 sa0, sa1, sb0, sb1;
    attn_qk<DK>(Kb, l32, hi, qf, sa0, sa1);
    ATP_LWRITEK(B, 1, 1); ATP_GLOADK(B, 3);
    for (int j = 0; j < ntiles; j += 2) {
        ATT_BAR();
        if (j + 1 < wtiles) attn_qk<DK>(Kb + KBYTES, l32, hi, qf, sb0, sb1);
        if (j < wtiles) attn_sm_pv<DV, MODE>(sa0, sa1, Vb, Cb, j, q0w, qrow, l32, hi, o, mrun, lrun);
        ATP_LWRITEK(A, 0, j + 2); ATP_GLOADK(A, j + 4);
        ATP_LWRITEV(B, 1, j + 1); ATP_GLOADV(B, j + 3);
        ATT_BAR();
        if (j + 2 < wtiles) attn_qk<DK>(Kb, l32, hi, qf, sa0, sa1);
        if (j + 1 < wtiles) attn_sm_pv<DV, MODE>(sb0, sb1, Vb + VBYTES, Cb + 64, j + 1, q0w, qrow, l32, hi, o, mrun, lrun);
        ATP_LWRITEK(B, 1, j + 3); ATP_GLOADK(B, j + 5);
        ATP_LWRITEV(A, 0, j + 2); ATP_GLOADV(A, j + 4);
    }
    ATT_BAR();
#undef ATP_GLOADK
#undef ATP_GLOADV
#undef ATP_LWRITEK
#undef ATP_LWRITEV
    const float lt = lrun + __shfl_xor(lrun, 32);
    const float inv = 1.0f / lt;
    bf16_t* orow = a.o + (size_t)qrow * a.op + 4 * hi;
#pragma unroll
    for (int dvh = 0; dvh < DV / 32; ++dvh)
#pragma unroll
        for (int rq = 0; rq < 4; ++rq) {
            f32x4 v; v[0] = o[dvh][4 * rq] * inv; v[1] = o[dvh][4 * rq + 1] * inv; v[2] = o[dvh][4 * rq + 2] * inv; v[3] = o[dvh][4 * rq + 3] * inv;
            st4(orow + dvh * 32 + 8 * rq, v);
        }
}

constexpr int XA_KP = 136, XA_VP = 260, XA_KBYTES = 256 * XA_KP * 2, XA_VBYTES = 128 * XA_VP * 2;
DI void attn_xa_block(LAS unsigned char* lds, const bf16_t* kg, const bf16_t* vg, int kvp, const bf16_t* qg, int qp, bf16_t* og, int op, const int q0, const int nunits, const int tid_in) {
    int tid = tid_in; asm volatile("" : "+v"(tid));
    LAS unsigned char* Kb = lds; LAS unsigned char* Vb = lds + XA_KBYTES;
    const int wave = tid >> 6, lane = tid & 63, l32 = lane & 31, hi = lane >> 5;
#pragma unroll
    for (int p = 0; p < 8; ++p) { const int ci = tid + 512 * p, row = ci >> 4, cc = ci & 15;
        *(LAS u32x4*)(Kb + (row * XA_KP + cc * 8) * 2) = *(const u32x4*)(kg + (size_t)row * kvp + cc * 8); }
#pragma unroll
    for (int p = 0; p < 4; ++p) { const int ci = tid + 512 * p, kp2 = ci >> 4, dvg = ci & 15;
        const bf16_t* vs = vg + (size_t)(2 * kp2) * kvp + dvg * 8; const u32x4 v0 = *(const u32x4*)vs, v1 = *(const u32x4*)(vs + kvp);
        LAS unsigned char* vd = Vb + ((dvg * 8) * XA_VP + 2 * kp2) * 2;
#pragma unroll
        for (int w = 0; w < 4; ++w) { *(LAS unsigned*)(vd + (2 * w) * XA_VP * 2) = (v0[w] & 0xffffu) | (v1[w] << 16); *(LAS unsigned*)(vd + (2 * w + 1) * XA_VP * 2) = (v0[w] >> 16) | (v1[w] & 0xffff0000u); } }
    __syncthreads();
#pragma unroll 1
    for (int un = 0; un < nunits; ++un) {
        const int qrow = q0 + 256 * un + 32 * wave + l32;
        bf16x8 qf[8];
#pragma unroll
        for (int ds = 0; ds < 8; ++ds) qf[ds] = *(const bf16x8*)(qg + (size_t)qrow * qp + ds * 16 + 8 * hi);
        f32x16 o[4];
#pragma unroll
        for (int i = 0; i < 4; ++i)
#pragma unroll
            for (int r = 0; r < 16; ++r) o[i][r] = 0.f;
        float mrun = -__builtin_inff(), lrun = 0.f;
#pragma unroll 1
        for (int j = 0; j < 4; ++j) attn_tile<128, 128, 2, XA_VP>(Kb + j * 64 * XA_KP * 2, Vb + j * 64 * 2, nullptr, j, 0, qrow, l32, hi, 0.f, qf, o, mrun, lrun);
        const float lt = lrun + __shfl_xor(lrun, 32);
        const float inv = 1.0f / lt;
        bf16_t* orow = og + (size_t)qrow * op + 4 * hi;
#pragma unroll
        for (int dvh = 0; dvh < 4; ++dvh)
#pragma unroll
            for (int rq = 0; rq < 4; ++rq) {
                f32x4 v; v[0] = o[dvh][4 * rq] * inv; v[1] = o[dvh][4 * rq + 1] * inv; v[2] = o[dvh][4 * rq + 2] * inv; v[3] = o[dvh][4 * rq + 3] * inv;
                st4(orow + dvh * 32 + 8 * rq, v);
            }
    }
    __syncthreads();
}

template <int DK, int DV, int MODE, int K1C>
DI void attn_unit_s(LAS unsigned char* lds, const AttnP& a, const int q0, const int tid_in) {
    int tid = tid_in; asm volatile("" : "+v"(tid));
    constexpr int KP = DK + 8, VP = 260;
    constexpr int KBYTES = 256 * KP * 2, VBYTES = DV * VP * 2;
    constexpr int KCH = DK / 8, NKC = 256 * KCH, KPT = NKC / 512;
    constexpr int VCH = DV / 8, NVI = 128 * VCH, VPT = NVI / 512;
    LAS unsigned char* Kb = lds; LAS unsigned char* Vb = lds + KBYTES; LAS float* Cb = (LAS float*)(lds + KBYTES + VBYTES);
    const int wave = tid >> 6, lane = tid & 63, l32 = lane & 31, hi = lane >> 5;
    const int q0w = q0 + 32 * wave, qrow = q0w + l32;
    const int nsup = (q0 + 256) / 256;
    const int wtiles = (MODE == 0) ? ((q0w + 31) / 64 + 1) : (q0w / 64 + 1);
    bf16x8 qf[DK / 16];
#pragma unroll
    for (int ds = 0; ds < DK / 16; ++ds) qf[ds] = *(const bf16x8*)(a.q + (size_t)qrow * a.qp + ds * 16 + 8 * hi);
    f32x16 o[DV / 32];
#pragma unroll
    for (int i = 0; i < DV / 32; ++i)
#pragma unroll
        for (int r = 0; r < 16; ++r) o[i][r] = 0.f;
    float mrun = -__builtin_inff(), lrun = 0.f;
    u32x4 kr[KPT], vr[VPT][2]; float cr = 0.f;
#define ATS_GLOAD(S) do { \
        _Pragma("unroll") for (int p_ = 0; p_ < KPT; ++p_) { const int ci_ = tid + 512 * p_, row_ = ci_ / KCH, cc_ = ci_ % KCH; \
            const bf16_t* src_ = (cc_ < K1C) ? (a.k1 + (size_t)(256 * (S) + row_) * a.k1p + cc_ * 8) : (a.k2 + (size_t)(256 * (S) + row_) * a.k2p + (cc_ - K1C) * 8); \
            kr[p_] = *(const u32x4*)src_; } \
        _Pragma("unroll") for (int p_ = 0; p_ < VPT; ++p_) { const int ci_ = tid + 512 * p_, kp2_ = ci_ / VCH, dvg_ = ci_ % VCH; \
            const bf16_t* vs_ = a.v + (size_t)(256 * (S) + 2 * kp2_) * a.vp + dvg_ * 8; vr[p_][0] = *(const u32x4*)vs_; vr[p_][1] = *(const u32x4*)(vs_ + a.vp); } \
        if (MODE == 0 && tid < 256) cr = a.bias[256 * (S) + tid]; } while (0)
#define ATS_LWRITE() do { \
        _Pragma("unroll") for (int p_ = 0; p_ < KPT; ++p_) { const int ci_ = tid + 512 * p_, row_ = ci_ / KCH, cc_ = ci_ % KCH; \
            *(LAS u32x4*)(Kb + (row_ * KP + cc_ * 8) * 2) = kr[p_]; } \
        _Pragma("unroll") for (int p_ = 0; p_ < VPT; ++p_) { const int ci_ = tid + 512 * p_, kp2_ = ci_ / VCH, dvg_ = ci_ % VCH; \
            LAS unsigned char* vd_ = Vb + ((dvg_ * 8) * VP + 2 * kp2_) * 2; \
            _Pragma("unroll") for (int w_ = 0; w_ < 4; ++w_) { \
                *(LAS unsigned*)(vd_ + (2 * w_) * VP * 2) = (vr[p_][0][w_] & 0xffffu) | (vr[p_][1][w_] << 16); \
                *(LAS unsigned*)(vd_ + (2 * w_ + 1) * VP * 2) = (vr[p_][0][w_] >> 16) | (vr[p_][1][w_] & 0xffff0000u); } } \
        if (MODE == 0 && tid < 256) Cb[tid] = cr; } while (0)
    ATS_GLOAD(0);
#pragma unroll 1
    for (int S = 0; S < nsup; ++S) {
        ATT_BAR();
        ATS_LWRITE();
        if (S + 1 < nsup) ATS_GLOAD(S + 1);
        ATT_BAR();
#pragma unroll 1
        for (int t = 0; t < 4; ++t) {
            const int j = 4 * S + t;
            if (j < wtiles) attn_tile<DK, DV, MODE, VP>(Kb + t * 64 * KP * 2, Vb + t * 64 * 2, Cb + 64 * t, j, q0w, qrow, l32, hi, 0.f, qf, o, mrun, lrun);
        }
    }
    ATT_BAR();
#undef ATS_GLOAD
#undef ATS_LWRITE
    const float lt = lrun + __shfl_xor(lrun, 32);
    const float inv = 1.0f / lt;
    bf16_t* orow = a.o + (size_t)qrow * a.op + 4 * hi;
#pragma unroll
    for (int dvh = 0; dvh < DV / 32; ++dvh)
#pragma unroll
        for (int rq = 0; rq < 4; ++rq) {
            f32x4 v; v[0] = o[dvh][4 * rq] * inv; v[1] = o[dvh][4 * rq + 1] * inv; v[2] = o[dvh][4 * rq + 2] * inv; v[3] = o[dvh][4 * rq + 3] * inv;
            st4(orow + dvh * 32 + 8 * rq, v);
        }
}

template <int DK, int DV, int K1C>
DI void attn_unit_fd(LAS unsigned char* lds, const AttnP& a, const int q0, const int tid_in) {
    int tid = tid_in; asm volatile("" : "+v"(tid));
    constexpr int KP = DK + 8, VP = 260;
    constexpr int KBYTES = 256 * KP * 2, VBYTES = DV * VP * 2;
    constexpr int KCH = DK / 8, NKC = 256 * KCH, KPT = NKC / 512;
    constexpr int VCH = DV / 8, NVI = 128 * VCH, VPT = NVI / 512;
    LAS unsigned char* Kb = lds; LAS unsigned char* Vb = lds + KBYTES; LAS float* Cb = (LAS float*)(lds + KBYTES + VBYTES);
    volatile LAS unsigned* vote = (volatile LAS unsigned*)(Cb + 256);
    const int wave = tid >> 6, lane = tid & 63, l32 = lane & 31, hi = lane >> 5;
    const int q0w = q0 + 32 * wave, qrow = q0w + l32;
    const int nsup = (q0 + 256) / 256;
    const int wtiles = (q0w + 31) / 64 + 1;
    bf16x8 qf[DK / 16];
    float qn2 = 0.f;
#pragma unroll
    for (int ds = 0; ds < DK / 16; ++ds) {
        qf[ds] = *(const bf16x8*)(a.q + (size_t)qrow * a.qp + ds * 16 + 8 * hi);
#pragma unroll
        for (int e = 0; e < 8; ++e) { const float v = bf2f((unsigned short)qf[ds][e]); qn2 += v * v; }
    }
    qn2 += __shfl_xor(qn2, 32);
    const float bq = sqrtf(qn2) * a.kmax * 1.0009765625f + 1.0f;
    f32x16 o[DV / 32];
#pragma unroll
    for (int i = 0; i < DV / 32; ++i)
#pragma unroll
        for (int r = 0; r < 16; ++r) o[i][r] = 0.f;
    float mrun = -__builtin_inff(), lrun = 0.f;
    bool done = false;
    u32x4 kr[KPT], vr[VPT][2]; float cr = 0.f;
#define AFD_GLOAD(S) do { \
        _Pragma("unroll") for (int p_ = 0; p_ < KPT; ++p_) { const int ci_ = tid + 512 * p_, row_ = ci_ / KCH, cc_ = ci_ % KCH; \
            kr[p_] = *(const u32x4*)(a.k1 + (size_t)(256 * (S) + row_) * a.k1p + cc_ * 8); } \
        _Pragma("unroll") for (int p_ = 0; p_ < VPT; ++p_) { const int ci_ = tid + 512 * p_, kp2_ = ci_ / VCH, dvg_ = ci_ % VCH; \
            const bf16_t* vs_ = a.v + (size_t)(256 * (S) + 2 * kp2_) * a.vp + dvg_ * 8; vr[p_][0] = *(const u32x4*)vs_; vr[p_][1] = *(const u32x4*)(vs_ + a.vp); } \
        if (tid < 256) cr = a.bias[256 * (S) + tid]; } while (0)
#define AFD_LWRITE() do { \
        _Pragma("unroll") for (int p_ = 0; p_ < KPT; ++p_) { const int ci_ = tid + 512 * p_, row_ = ci_ / KCH, cc_ = ci_ % KCH; \
            *(LAS u32x4*)(Kb + (row_ * KP + cc_ * 8) * 2) = kr[p_]; } \
        _Pragma("unroll") for (int p_ = 0; p_ < VPT; ++p_) { const int ci_ = tid + 512 * p_, kp2_ = ci_ / VCH, dvg_ = ci_ % VCH; \
            LAS unsigned char* vd_ = Vb + ((dvg_ * 8) * VP + 2 * kp2_) * 2; \
            _Pragma("unroll") for (int w_ = 0; w_ < 4; ++w_) { \
                *(LAS unsigned*)(vd_ + (2 * w_) * VP * 2) = (vr[p_][0][w_] & 0xffffu) | (vr[p_][1][w_] << 16); \
                *(LAS unsigned*)(vd_ + (2 * w_ + 1) * VP * 2) = (vr[p_][0][w_] >> 16) | (vr[p_][1][w_] & 0xffff0000u); } } \
        if (tid < 256) Cb[tid] = cr; } while (0)
    AFD_GLOAD(nsup - 1);
#pragma unroll 1
    for (int S = nsup - 1; S >= 0; --S) {
        ATT_BAR();
        if (S != nsup - 1 && vote[S & 1] == 0u) break;
        AFD_LWRITE();
        if (S > 0) AFD_GLOAD(S - 1);
        if (tid == 0) vote[(S + 1) & 1] = 0u;
        ATT_BAR();
#pragma unroll 1
        for (int t = 3; t >= 0; --t) {
            const int j = 4 * S + t;
            if (j < wtiles && !done) {
                const float ub = bq - Cb[64 * t + 63] - mrun;
                if (__all(ub < -64.0f)) done = true;
                else attn_tile<DK, DV, 0, VP>(Kb + t * 64 * KP * 2, Vb + t * 64 * 2, Cb + 64 * t, j, q0w, qrow, l32, hi, 0.f, qf, o, mrun, lrun);
            }
        }
        if (!done && S > 0 && lane == 0) vote[(S - 1) & 1] = 1u;
    }
    ATT_BAR();
#undef AFD_GLOAD
#undef AFD_LWRITE
    const float lt = lrun + __shfl_xor(lrun, 32);
    const float inv = 1.0f / lt;
    bf16_t* orow = a.o + (size_t)qrow * a.op + 4 * hi;
#pragma unroll
    for (int dvh = 0; dvh < DV / 32; ++dvh)
#pragma unroll
        for (int rq = 0; rq < 4; ++rq) {
            f32x4 v; v[0] = o[dvh][4 * rq] * inv; v[1] = o[dvh][4 * rq + 1] * inv; v[2] = o[dvh][4 * rq + 2] * inv; v[3] = o[dvh][4 * rq + 3] * inv;
            st4(orow + dvh * 32 + 8 * rq, v);
        }
}
DI void fox_kmax_item(int item, const bf16_t* z, unsigned* kmax2bits, int tid) {
    const int bh = item >> 3, seg = item & 7, b = bh >> 2, h = bh & 3;
    const bf16_t* kp = z + (size_t)(b * SEQ + seg * 512 + tid) * ZP + ZC_FK + h * 64; float ss = 0.f;
#pragma unroll
    for (int c = 0; c < 8; ++c) { const u32x4 w = *(const u32x4*)(kp + 8 * c);
        ss += (bflo(w.x) * bflo(w.x) + bfhi(w.x) * bfhi(w.x)) + (bflo(w.y) * bflo(w.y) + bfhi(w.y) * bfhi(w.y)) + (bflo(w.z) * bflo(w.z) + bfhi(w.z) * bfhi(w.z)) + (bflo(w.w) * bflo(w.w) + bfhi(w.w) * bfhi(w.w)); }
#pragma unroll
    for (int o = 1; o < 64; o <<= 1) ss = fmaxf(ss, __shfl_xor(ss, o));
    if ((tid & 63) == 0) atomicMax(kmax2bits + bh, __float_as_uint(ss));
}

DI float wave_sum(float v) {
#pragma unroll
    for (int o = 1; o < 64; o <<= 1) v += __shfl_xor(v, o);
    return v;
}
DI void norm_row(const float* xr, const float* g, bf16_t* ob, float* of, int lane) {
    f32x4 v[4]; float ss = 0.f;
#pragma unroll
    for (int j = 0; j < 4; ++j) { v[j] = *(const f32x4*)(xr + 4 * lane + 256 * j); ss += (v[j][0] * v[j][0] + v[j][1] * v[j][1]) + (v[j][2] * v[j][2] + v[j][3] * v[j][3]); }
    const float rstd = rsqrtf(wave_sum(ss) * (1.f / 1024.f) + EPS);
#pragma unroll
    for (int j = 0; j < 4; ++j) {
        const f32x4 gg = *(const f32x4*)(g + 4 * lane + 256 * j);
        const f32x4 y = v[j] * rstd * gg;
        if (ob) st4(ob + 4 * lane + 256 * j, y); else *(f32x4*)(of + 4 * lane + 256 * j) = y;
    }
}
DI void rawnorm_phase(const float* x, bf16_t* ob, float* ssout, int nrows, int tid) {
    const int gw = blockIdx.x * 8 + (tid >> 6), ngw = gridDim.x * 8, lane = tid & 63;
    int r = gw;
    for (; r + 3 * ngw < nrows; r += 4 * ngw) {
        f32x4 v[4][4];
#pragma unroll
        for (int q = 0; q < 4; ++q)
#pragma unroll
            for (int j = 0; j < 4; ++j) v[q][j] = *(const f32x4*)(x + (size_t)(r + q * ngw) * 1024 + 4 * lane + 256 * j);
#pragma unroll
        for (int q = 0; q < 4; ++q) {
            float ss = 0.f;
#pragma unroll
            for (int j = 0; j < 4; ++j) { const f32x4 w = v[q][j]; ss += (w[0] * w[0] + w[1] * w[1]) + (w[2] * w[2] + w[3] * w[3]); st4(ob + (size_t)(r + q * ngw) * 1024 + 4 * lane + 256 * j, w); }
            ss = wave_sum(ss);
            if (lane < 16) ssout[(size_t)(r + q * ngw) * 16 + lane] = (lane == 0) ? ss : 0.f;
        }
    }
    for (; r < nrows; r += ngw) {
        const float* xr = x + (size_t)r * 1024; float ss = 0.f;
#pragma unroll
        for (int j = 0; j < 4; ++j) { const f32x4 v = *(const f32x4*)(xr + 4 * lane + 256 * j); ss += (v[0] * v[0] + v[1] * v[1]) + (v[2] * v[2] + v[3] * v[3]); st4(ob + (size_t)r * 1024 + 4 * lane + 256 * j, v); }
        ss = wave_sum(ss);
        if (lane < 16) ssout[(size_t)r * 16 + lane] = (lane == 0) ? ss : 0.f;
    }
}
DI void norm_phase(const float* x, const float* g, bf16_t* ob, float* of, int nrows, int tid) {
    const int gw = blockIdx.x * 8 + (tid >> 6), ngw = gridDim.x * 8, lane = tid & 63;
    for (int r = gw; r < nrows; r += ngw) norm_row(x + (size_t)r * 1024, g, ob ? ob + (size_t)r * 1024 : nullptr, of ? of + (size_t)r * 1024 : nullptr, lane);
}

DI int map_win(int n) {
    if (n < 768) return n;
    if (n < 1792) return n + 4;
    if (n < 2720) return n + 20;
    if (n < 2724) return 768 + (n - 2720);
    if (n < 2736) return -1;
    if (n < 2752) return 1796 + (n - 2736);
    return -1;
}
DI void transpose_job(const float* src, int Ns, int K, int Nd, int mapmode, int off, bf16_t* dst, LAS float* tile, int tid, int rot, const float* ks = nullptr) {
    const int nkt = K / 64, ntiles = (Nd / 256) * nkt;
    const int G = gridDim.x;
    for (int t = (blockIdx.x + rot) % G; t < ntiles; t += G) {
        const int n0 = (t / nkt) * 256, k0 = (t % nkt) * 64;
        int sc[4];
#pragma unroll
        for (int q = 0; q < 4; ++q) { const int nn = n0 + 64 * q + (tid & 63); sc[q] = mapmode ? map_win(nn) : off + nn; }
#pragma unroll
        for (int p = 0; p < 8; ++p) {
            const int kk = (tid >> 6) + 8 * p;
            const float sk = ks ? ks[k0 + kk] : 1.f;
            const float* sr = src + (size_t)(k0 + kk) * Ns;
#pragma unroll
            for (int q = 0; q < 4; ++q) tile[kk * 257 + 64 * q + (tid & 63)] = (sc[q] >= 0) ? sr[sc[q]] * sk : 0.f;
        }
        __syncthreads();
        const int kc = tid & 7;
#pragma unroll
        for (int q = 0; q < 4; ++q) {
            const int nl = (tid >> 3) + 64 * q;
            const LAS float* s = tile + (kc * 8) * 257 + nl;
            u32x4 w; w.x = pk2(s[0], s[257]); w.y = pk2(s[2 * 257], s[3 * 257]); w.z = pk2(s[4 * 257], s[5 * 257]); w.w = pk2(s[6 * 257], s[7 * 257]);
            *(u32x4*)(dst + (size_t)(n0 + nl) * K + k0 + kc * 8) = w;
        }
        __syncthreads();
    }
}

constexpr size_t WS_CTL = 0;
constexpr size_t WL_WIN = 0, WL_WG = WL_WIN + (size_t)2816 * 1024 * 2, WL_UPF = WL_WG + (size_t)3072 * 1024 * 2, WL_UPG = WL_UPF + (size_t)1024 * 256 * 2,
                 WL_UPM = WL_UPG + (size_t)1024 * 512 * 2, WL_OUT = WL_UPM + (size_t)1024 * 256 * 2, WL_XQ = WL_OUT + (size_t)1024 * 1024 * 2, WL_XKV = WL_XQ + (size_t)512 * 1024 * 2,
                 WL_XO = WL_XKV + (size_t)1024 * 1024 * 2, WL_W1 = WL_XO + (size_t)1024 * 512 * 2, WL_W2 = WL_W1 + (size_t)4096 * 1024 * 2, WL_WM = WL_W2 + (size_t)4096 * 1024 * 2,
                 WL_SIZE = WL_WM + (size_t)1024 * 384 * 2;
constexpr size_t WS_W = 65536;
constexpr size_t WS_LF = WS_W + 2 * WL_SIZE;
constexpr size_t WS_CUM = WS_LF + (size_t)T_TOK * 4 * 4;
constexpr size_t WS_SSQ = WS_CUM + (size_t)T_TOK * 4 * 4;
constexpr size_t WS_GA = WS_SSQ + (size_t)2 * T_TOK * 8 * 4;
constexpr size_t WS_MEMN = WS_GA + (size_t)2048 * 64 * 4;
constexpr size_t WS_KVX = WS_MEMN + (size_t)2 * 2048 * 1024 * 2;
constexpr size_t WS_UT = WS_KVX + (size_t)2 * 2048 * 1024 * 2;
constexpr size_t WS_R0 = WS_UT + (size_t)2048 * 128 * 64 * 2;
constexpr size_t R_Z = WS_R0, R_O = R_Z + (size_t)T_TOK * ZP * 2, R_QH = R_O + (size_t)T_TOK * 1024 * 2, R_KVB = R_QH + (size_t)T_TOK * 384 * 2, R_H = R_KVB + (size_t)T_TOK * 512 * 2,
                 R_END = R_H + (size_t)T_TOK * 1024 * 2;
constexpr size_t R_GTMP = R_Z, R_Y = R_Z + (size_t)T_TOK * 1024 * 2;
constexpr size_t R_QX = R_Z, R_OX = R_Z + (size_t)T_TOK * 512 * 2;
constexpr size_t R_HID = R_Z;
static_assert(R_HID + (size_t)T_TOK * 4096 * 2 <= R_H, "workspace aliasing");
constexpr size_t WS_SSX = R_END;
constexpr size_t WS_NEED = WS_SSX + (size_t)7 * T_TOK * 16 * 4;

struct Params {
    const void* p[28];
};

constexpr int LDS_BYTES = 139264 + 64;
DI const float* inp(const Params& P, int i) { asm volatile("" : "+s"(i)); return (const float*)P.p[i]; }
DI float* outp(const Params& P) { int i = 26; asm volatile("" : "+s"(i)); return (float*)P.p[i]; }
DI unsigned char* wsp(const Params& P) { int i = 27; asm volatile("" : "+s"(i)); return (unsigned char*)P.p[i]; }

DI void gla_a_unit(int unit, const bf16_t* z, const float* wg, const float* bgate, bf16_t* uT, float* ga, int lane) {
    const int b = unit >> 8, h = (unit >> 6) & 3, c = unit & 63;
    const int l32 = lane & 31, hi = lane >> 5;
    const bf16_t* zb = z + (size_t)(b * SEQ + c * 64) * ZP;
    bf16x8 gfr[2];
#pragma unroll
    for (int tt = 0; tt < 2; ++tt) gfr[tt] = *(const bf16x8*)(zb + (size_t)(l32 + 32 * tt) * ZP + ZC_GLOW + 8 * hi);
    unsigned short kraw[2][2][16];
#pragma unroll
    for (int dt = 0; dt < 2; ++dt)
#pragma unroll
        for (int tt = 0; tt < 2; ++tt)
#pragma unroll
            for (int r = 0; r < 16; ++r) kraw[dt][tt][r] = zb[(size_t)(crow(r, hi) + 32 * tt) * ZP + ZC_GK + h * 64 + l32 + 32 * dt];
    bf16x8 vt[2][2];
#define GA_VLOAD(ET) do { const bf16_t* vb_ = zb + ZC_GV + h * 128 + 32 * (ET) + l32 + (size_t)(4 * hi) * ZP; \
        _Pragma("unroll") for (int tt = 0; tt < 2; ++tt) _Pragma("unroll") for (int s = 0; s < 2; ++s) { bf16x8 f_; \
            _Pragma("unroll") for (int j = 0; j < 8; ++j) { const int t_ = (j & 3) + 8 * (2 * s + (j >> 2)) + 32 * tt; f_[j] = (short)vb_[(size_t)t_ * ZP]; } \
            vt[tt][s] = f_; } } while (0)
    GA_VLOAD(0);
    __builtin_amdgcn_sched_barrier(0);
    bf16x8 kd[2][2][2];
#pragma unroll
    for (int dt = 0; dt < 2; ++dt) {
        const int d = l32 + 32 * dt, col = h * 64 + d;
        float wv[8];
#pragma unroll
        for (int j = 0; j < 8; ++j) wv[j] = wg[(8 * hi + j) * 256 + col];
        const bf16x8 wb = pack8(wv[0], wv[1], wv[2], wv[3], wv[4], wv[5], wv[6], wv[7]);
        const float bg = bgate[col];
        f32x16 pre[2];
#pragma unroll
        for (int tt = 0; tt < 2; ++tt) {
            f32x16 zz;
#pragma unroll
            for (int r = 0; r < 16; ++r) zz[r] = 0.f;
            pre[tt] = MFMA32(gfr[tt], wb, zz);
        }
        float tot[8];
#pragma unroll
        for (int tt = 0; tt < 2; ++tt)
#pragma unroll
            for (int q = 0; q < 4; ++q) {
                float run = 0.f;
#pragma unroll
                for (int jj = 0; jj < 4; ++jj) { run += logsig(pre[tt][4 * q + jj] + bg) * (1.f / 16.f); pre[tt][4 * q + jj] = run; }
                tot[4 * tt + q] = run;
            }
        float run = 0.f;
#pragma unroll
        for (int m = 0; m < 8; ++m) {
            const float pm = __shfl_xor(tot[m], 32);
            const float off = run + (hi ? pm : 0.f);
            run += tot[m] + pm;
#pragma unroll
            for (int jj = 0; jj < 4; ++jj) pre[m >> 2][4 * (m & 3) + jj] += off;
        }
        const float end = run;
#pragma unroll
        for (int tt = 0; tt < 2; ++tt)
#pragma unroll
            for (int s = 0; s < 2; ++s) {
                float x[8];
#pragma unroll
                for (int j = 0; j < 8; ++j) { const int r = 8 * s + j; x[j] = bf2f(kraw[dt][tt][r]) * __builtin_amdgcn_exp2f((end - pre[tt][r]) * LOG2E); }
                kd[dt][tt][s] = pack8(x[0], x[1], x[2], x[3], x[4], x[5], x[6], x[7]);
            }
        if (hi == 0) ga[(size_t)unit * 64 + d] = __builtin_amdgcn_exp2f(end * LOG2E);
    }
#pragma unroll
    for (int et = 0; et < 4; ++et) {
        bf16x8 vc[2][2];
#pragma unroll
        for (int tt = 0; tt < 2; ++tt)
#pragma unroll
            for (int s = 0; s < 2; ++s) vc[tt][s] = vt[tt][s];
        if (et + 1 < 4) GA_VLOAD(et + 1);
        __builtin_amdgcn_sched_barrier(0);
#pragma unroll
        for (int dt = 0; dt < 2; ++dt) {
            f32x16 acc;
#pragma unroll
            for (int r = 0; r < 16; ++r) acc[r] = 0.f;
#pragma unroll
            for (int tt = 0; tt < 2; ++tt)
#pragma unroll
                for (int s = 0; s < 2; ++s) acc = MFMA32(kd[dt][tt][s], vc[tt][s], acc);
            bf16_t* up = uT + ((size_t)unit * 128 + 32 * et + l32) * 64 + 32 * dt + 4 * hi;
#pragma unroll
            for (int q4 = 0; q4 < 4; ++q4) { f32x4 v; v[0] = acc[4 * q4]; v[1] = acc[4 * q4 + 1]; v[2] = acc[4 * q4 + 2]; v[3] = acc[4 * q4 + 3]; st4(up + 8 * q4, v); }
        }
        __builtin_amdgcn_sched_barrier(0);
    }
#undef GA_VLOAD
}
DI void gla_b_phase(bf16_t* uT, const float* ga, int tid) {
    for (int gid = blockIdx.x * 512 + tid; gid < 32 * 4096; gid += gridDim.x * 512) {
        const int bh = gid >> 12, idx = gid & 4095, elem = idx * 2, d = elem & 63;
        unsigned* up = (unsigned*)(uT + (size_t)bh * 64 * 8192 + elem);
        const float* ap = ga + (size_t)bh * 64 * 64 + d;
        float s0 = 0.f, s1 = 0.f;
        unsigned u[32]; f32x2 av[32];
#pragma unroll 1
        for (int c0 = 0; c0 < 64; c0 += 32) {
#pragma unroll
            for (int i = 0; i < 32; ++i) { u[i] = up[(size_t)(c0 + i) * 4096]; av[i] = *(const f32x2*)(ap + (c0 + i) * 64); }
#pragma unroll
            for (int i = 0; i < 32; ++i) { s0 = av[i][0] * s0 + bflo(u[i]); s1 = av[i][1] * s1 + bfhi(u[i]); up[(size_t)(c0 + i) * 4096] = pk2(s0, s1); }
        }
    }
}
DI void gla_c_unit(int w, const bf16_t* z, const bf16_t* uT, const float* gout, bf16_t* obuf, int lane) {
    const int bhc = w >> 1, th = w & 1;
    const int b = bhc >> 8, h = (bhc >> 6) & 3, c = bhc & 63;
    const int l32 = lane & 31, hi = lane >> 5;
    const int row = b * SEQ + c * 64 + 32 * th + l32;
    const bf16_t* zr = z + (size_t)row * ZP;
    bf16x8 qb[4];
#pragma unroll
    for (int s = 0; s < 4; ++s) qb[s] = *(const bf16x8*)(zr + ZC_GQ + h * 64 + 16 * s + 8 * hi);
    f32x16 acc[4]; float ss = 0.f;
#pragma unroll
    for (int et = 0; et < 4; ++et) {
#pragma unroll
        for (int r = 0; r < 16; ++r) acc[et][r] = 0.f;
        const bf16_t* sp = uT + ((size_t)bhc * 128 + 32 * et + l32) * 64 + 8 * hi;
#pragma unroll
        for (int s = 0; s < 4; ++s) acc[et] = MFMA32(*(const bf16x8*)(sp + 16 * s), qb[s], acc[et]);
#pragma unroll
        for (int r = 0; r < 16; ++r) ss += acc[et][r] * acc[et][r];
    }
    ss += __shfl_xor(ss, 32);
    const float sc = 0.125f * rsqrtf(ss * (1.f / 8192.f) + EPS);
#pragma unroll
    for (int et = 0; et < 4; ++et)
#pragma unroll
        for (int q4 = 0; q4 < 4; ++q4) {
            const int e0 = 8 * q4 + 4 * hi + 32 * et;
            const f32x4 g = *(const f32x4*)(gout + e0);
            const u32x2 rr = *(const u32x2*)(zr + ZC_GR + h * 128 + e0);
            f32x4 v;
            v[0] = acc[et][4 * q4] * sc * g[0] * bflo(rr.x); v[1] = acc[et][4 * q4 + 1] * sc * g[1] * bfhi(rr.x);
            v[2] = acc[et][4 * q4 + 2] * sc * g[2] * bflo(rr.y); v[3] = acc[et][4 * q4 + 3] * sc * g[3] * bfhi(rr.y);
            st4(obuf + (size_t)row * 1024 + 256 + h * 128 + e0, v);
        }
}
DI void fox_cumsum_block(int bh, const float* lf, float* cum, LAS float* red, int tid) {
    const int b = bh >> 2, h = bh & 3, lane = tid & 63, wave = tid >> 6;
    const float* src = lf + ((size_t)(b * SEQ + tid * 8)) * 4 + h;
    float v[8];
#pragma unroll
    for (int i = 0; i < 8; ++i) v[i] = src[i * 4];
#pragma unroll
    for (int i = 1; i < 8; ++i) v[i] += v[i - 1];
    const float tot = v[7];
    float x = tot;
#pragma unroll
    for (int o = 1; o < 64; o <<= 1) { const float y = __shfl_up(x, o); if (lane >= o) x += y; }
    if (lane == 63) red[wave] = x;
    __syncthreads();
    float base = x - tot;
#pragma unroll
    for (int w = 0; w < 8; ++w) if (w < wave) base += red[w];
    float* dst = cum + (size_t)bh * SEQ + tid * 8;
    f32x4 o0, o1;
#pragma unroll
    for (int i = 0; i < 4; ++i) { o0[i] = v[i] + base; o1[i] = v[4 + i] + base; }
    *(f32x4*)dst = o0; *(f32x4*)(dst + 4) = o1;
    __syncthreads();
}
#define XB_TMO      128
#define XB_XCNT(j)  (256  + 64 * (j))
#define XB_XSUB(j)  (1280 + 64 * (j))
#define XB_XGEN(j)  (2304 + 64 * (j))
#define XB_TOP      3328
#define XB_TOPGEN   3392
#define XCD_BAR_WORDS 3456
#define XB_SPIN_CAP (1u << 18)

__device__ __forceinline__ unsigned xb_ld(unsigned* p)              { return __hip_atomic_load(p, __ATOMIC_RELAXED, __HIP_MEMORY_SCOPE_AGENT); }
__device__ __forceinline__ unsigned xb_add(unsigned* p, unsigned v) { return __hip_atomic_fetch_add(p, v, __ATOMIC_RELAXED, __HIP_MEMORY_SCOPE_AGENT); }
__device__ __forceinline__ unsigned xb_xcc_id() { return (unsigned)__builtin_amdgcn_s_getreg((3 << 11) | 20) & 0xFu; }
#define XB_SPIN(cond, bar) do { unsigned _sp = 0; while (cond) { __builtin_amdgcn_s_sleep(1); \
    if ((++_sp & 255u) == 0u) { if (xb_ld(&(bar)[XB_TMO])) break; if (_sp > XB_SPIN_CAP) { atomicAdd(&(bar)[XB_TMO], 1u); break; } } } } while (0)

struct XcdBarrier {
    unsigned* bar; unsigned x;
    volatile LAS unsigned* st;
};

__device__ __forceinline__ XcdBarrier xcd_barrier_post(unsigned* bar, volatile LAS unsigned* st) {
    XcdBarrier b; b.bar = bar; b.x = xb_xcc_id(); b.st = st;
    if (threadIdx.x == 0) (void)xb_add(&bar[XB_XCNT(b.x)], 1u);
    return b;
}
__device__ __forceinline__ void xcd_barrier_complete(unsigned* bar, unsigned x, unsigned& nloc, unsigned& nx) {
    const unsigned G = gridDim.x * gridDim.y * gridDim.z;
    unsigned sum, cnt, mine, sp = 0u;
    for (;;) {
        sum = 0u; cnt = 0u; mine = 0u;
#pragma unroll
        for (unsigned j = 0; j < 16; ++j) { const unsigned c = xb_ld(&bar[XB_XCNT(j)]); sum += c; cnt += (c > 0u) ? 1u : 0u; mine = (j == x) ? c : mine; }
        if (sum == G) break;
        __builtin_amdgcn_s_sleep(1);
        if ((++sp & 255u) == 0u) { if (xb_ld(&bar[XB_TMO])) break; if (sp > XB_SPIN_CAP) { atomicAdd(&bar[XB_TMO], 1u); break; } }
    }
    nloc = mine > 0u ? mine : 1u; nx = cnt > 0u ? cnt : 1u;
}

__device__ __forceinline__ void xcd_barrier(const XcdBarrier& b) {
    asm volatile("s_waitcnt vmcnt(0)" ::: "memory");
    __syncthreads();
    if (threadIdx.x == 0) {
        unsigned* bar = b.bar;
        __builtin_amdgcn_s_waitcnt(0);
        unsigned nloc = b.st[0], nx = b.st[1];
        if (nloc == 0u) { xcd_barrier_complete(bar, b.x, nloc, nx); b.st[0] = nloc; b.st[1] = nx; }
        const unsigned old = xb_add(&bar[XB_XSUB(b.x)], 1u);
        const unsigned gen = old / nloc;
        if (old + 1u == (gen + 1u) * nloc) {
            __builtin_amdgcn_fence(__ATOMIC_RELEASE, "agent");
            asm volatile("s_waitcnt vmcnt(0)" ::: "memory");
            const unsigned og = xb_add(&bar[XB_TOP], 1u);
            const unsigned tg = og / nx;
            if (og + 1u == (tg + 1u) * nx) xb_add(&bar[XB_TOPGEN], 1u);
            else XB_SPIN(xb_ld(&bar[XB_TOPGEN]) == tg, bar);
            __builtin_amdgcn_fence(__ATOMIC_ACQUIRE, "agent");
            xb_add(&bar[XB_XGEN(b.x)], 1u);
            asm volatile("s_waitcnt vmcnt(0)" ::: "memory");
        } else {
            XB_SPIN(xb_ld(&bar[XB_XGEN(b.x)]) == gen, bar);
            __builtin_amdgcn_fence(__ATOMIC_ACQUIRE, "agent");
            asm volatile("s_waitcnt vmcnt(0)" ::: "memory");
        }
    }
    __syncthreads();

}
DI int ltid() { int t = threadIdx.x; asm volatile("" : "+v"(t)); return t; }
#define PHASE_PRE const int tid = ltid(); const int lane = tid & 63, wave = tid >> 6; const int G = gridDim.x; (void)lane; (void)wave; (void)G;
#define WSPTRS PHASE_PRE \
    unsigned char* ws = wsp(P); float* xres = outp(P); (void)xres; \
    float* lf = (float*)(ws + WS_LF); float* cum = (float*)(ws + WS_CUM); float* ga = (float*)(ws + WS_GA); bf16_t* uT = (bf16_t*)(ws + WS_UT); \
    bf16_t* zb = (bf16_t*)(ws + R_Z); bf16_t* hb = (bf16_t*)(ws + R_H); bf16_t* ob = (bf16_t*)(ws + R_O); bf16_t* qh = (bf16_t*)(ws + R_QH); bf16_t* kvb = (bf16_t*)(ws + R_KVB); \
    bf16_t* gtmp = (bf16_t*)(ws + R_GTMP); bf16_t* yb = (bf16_t*)(ws + R_Y); bf16_t* qx = (bf16_t*)(ws + R_QX); bf16_t* ox = (bf16_t*)(ws + R_OX); \
    bf16_t* hid = (bf16_t*)(ws + R_HID); \
    float* ssx = (float*)(ws + WS_SSX); (void)ssx; \
    const unsigned char* wl = ws + WS_W + (size_t)l * WL_SIZE; float* ssq = (float*)(ws + WS_SSQ) + (size_t)l * T_TOK * 8; bf16_t* kvx = (bf16_t*)(ws + WS_KVX) + (size_t)l * 2048 * 1024; \
    (void)lf; (void)cum; (void)ga; (void)uT; (void)zb; (void)hb; (void)ob; (void)qh; (void)kvb; (void)gtmp; (void)yb; (void)qx; (void)ox; (void)hid; (void)wl; (void)ssq; (void)kvx;
template <int l>
DI void layer_body(const Params& P, LAS unsigned char* lds, const XcdBarrier& bar) {
        { WSPTRS
            EpiA e{}; e.mode = 1; e.z = zb; e.lf = lf; e.ssq = ssq; e.bfox = inp(P, 4) + l * 4; e.rs_in = ssx + (size_t)(l == 0 ? 6 : 2) * T_TOK * 16;
            run_gemm(lds, hb, 1024, (const bf16_t*)(wl + WL_WIN), T_TOK, 2816, 1024, e, 0);
            EpiB e2{}; e2.mode = 0; e2.out = kvx; e2.ldc = 1024; e2.scale = 1.f;
            run_gemm(lds, (const bf16_t*)(ws + WS_MEMN) + (size_t)l * 2048 * 1024, 1024, (const bf16_t*)(wl + WL_XKV), 2048, 1024, 1024, e2, 128);
        }
        xcd_barrier(bar);
        { WSPTRS
            EpiA e{}; e.mode = 2; e.ssq = ssq; e.qh = qh; e.kvb = kvb;
            run_gemm(lds, zb + ZC_MQ, ZP, (const bf16_t*)(wl + WL_WM), T_TOK, 1024, 384, e, 0);
            const float* wg = inp(P, 5) + (size_t)l * 16 * 256; const float* bgate = inp(P, 6) + l * 256;
            for (int u = blockIdx.x * 8 + wave; u < 2048; u += G * 8) gla_a_unit(u, zb, wg, bgate, uT, ga, lane);
            for (int bh = (blockIdx.x + 128) % G; bh < 32; bh += G) fox_cumsum_block(bh, lf, cum, (LAS float*)lds, tid);
            for (int it = blockIdx.x; it < 256; it += G) fox_kmax_item(it, zb, (unsigned*)(ws + WS_CTL + 32768) + l * 32, tid);
        }
        xcd_barrier(bar);
        { WSPTRS
            gla_b_phase(uT, ga, tid);
            for (int vb = blockIdx.x; vb < 256; vb += G) {
                const int xcd = vb & 7, idx = vb >> 3;
                const int bh = xcd * 4 + (idx >> 3), sidx = idx & 7;
                const int b = bh >> 2, h = bh & 3;
                AttnP af; af.q = zb + (size_t)(b * SEQ) * ZP + ZC_FQ + h * 64; af.qp = ZP;
                af.k1 = zb + (size_t)(b * SEQ) * ZP + ZC_FK + h * 64; af.k1p = ZP; af.k2 = af.k1; af.k2p = ZP;
                af.v = zb + (size_t)(b * SEQ) * ZP + ZC_FV + h * 64; af.vp = ZP;
                af.o = ob + (size_t)(b * SEQ) * 1024 + h * 64; af.op = 1024; af.bias = cum + (size_t)bh * SEQ; af.kmax = sqrtf(((const float*)(ws + WS_CTL + 32768))[l * 32 + bh]);
                AttnP am; am.q = qh + (size_t)(b * SEQ) * 384 + h * 96; am.qp = 384;
                am.k1 = kvb + (size_t)(b * SEQ) * 512 + h * 128; am.k1p = 512; am.k2 = zb + (size_t)(b * SEQ) * ZP + ZC_MKR; am.k2p = ZP;
                am.v = kvb + (size_t)(b * SEQ) * 512 + h * 128 + 64; am.vp = 512;
                am.o = ob + (size_t)(b * SEQ) * 1024 + 768 + h * 64; am.op = 1024; am.bias = nullptr; am.kmax = 0.f;
                attn_unit_fd<64, 64, 8>(lds, af, (15 - sidx) * 256, tid);
                attn_unit_s<96, 64, 1, 8>(lds, am, (15 - sidx) * 256, tid);
                attn_unit_fd<64, 64, 8>(lds, af, sidx * 256, tid);
                attn_unit_s<96, 64, 1, 8>(lds, am, sidx * 256, tid);
            }
        }
        xcd_barrier(bar);
        { WSPTRS
            const float* gout = inp(P, 7) + l * 128;
            for (int w = blockIdx.x * 8 + wave; w < 4096; w += G * 8) gla_c_unit(w, zb, uT, gout, ob, lane);
        }
        xcd_barrier(bar);
        { WSPTRS
            const float* bgb = inp(P, 12) + (size_t)l * 3072;
            for (int br = 0; br < 3; ++br) {
                EpiB eg{}; eg.mode = 2; eg.out = gtmp; eg.ldc = 1024; eg.bias = bgb + br * 1024; eg.rs_in = ssx + (size_t)(l == 0 ? 6 : 2) * T_TOK * 16;
                run_gemm(lds, hb, 1024, (const bf16_t*)(wl + WL_WG) + (size_t)br * 1024 * 1024, T_TOK, 1024, 1024, eg, 0);
                EpiB eu{}; eu.mode = 3; eu.out = yb; eu.ldc = 1024; eu.gate = gtmp; eu.first = (br == 0);
                const bf16_t* Ab = ob + (br == 0 ? 0 : (br == 1 ? 256 : 768));
                const bf16_t* Wb = (const bf16_t*)(wl + (br == 0 ? WL_UPF : (br == 1 ? WL_UPG : WL_UPM)));
                run_gemm(lds, Ab, 1024, Wb, T_TOK, 1024, (br == 1) ? 512 : 256, eu, 0);
            }
        }
        xcd_barrier(bar);
        { WSPTRS
            EpiA e{}; e.mode = 0; e.xin_b = hb; e.xout_b = hb; e.ss_out = ssx + (size_t)(l * 3) * T_TOK * 16;
            run_gemm(lds, yb, 1024, (const bf16_t*)(wl + WL_OUT), T_TOK, 1024, 1024, e, 0);
        }
        xcd_barrier(bar);
        { WSPTRS
            EpiB e{}; e.mode = 0; e.out = qx; e.ldc = 512; e.scale = QS_XA; e.rs_in = ssx + (size_t)(l * 3) * T_TOK * 16;
            run_gemm(lds, hb, 1024, (const bf16_t*)(wl + WL_XQ), T_TOK, 512, 1024, e, 0);
        }
        xcd_barrier(bar);
        { WSPTRS
            for (int up = blockIdx.x; up < 256; up += G) {
                const int b = up >> 5, h = (up >> 3) & 3, qp2 = up & 7;
                attn_xa_block(lds, kvx + (size_t)(b * MEMLEN) * 1024 + h * 128, kvx + (size_t)(b * MEMLEN) * 1024 + 512 + h * 128, 1024,
                              qx + (size_t)(b * SEQ) * 512 + h * 128, 512, ox + (size_t)(b * SEQ) * 512 + h * 128, 512, qp2 * 512, 2, tid);
            }
        }
        xcd_barrier(bar);
        { WSPTRS
            EpiA e{}; e.mode = 0; e.xin_b = hb; e.xout_b = hb; e.ss_out = ssx + (size_t)(l * 3 + 1) * T_TOK * 16;
            run_gemm(lds, ox, 512, (const bf16_t*)(wl + WL_XO), T_TOK, 1024, 512, e, 0);
        }
        xcd_barrier(bar);
        { WSPTRS
            EpiB e{}; e.mode = 1; e.out = hid; e.ldc = 4096; e.rs_in = ssx + (size_t)(l * 3 + 1) * T_TOK * 16;
            run_gemm(lds, hb, 1024, (const bf16_t*)(wl + WL_W1), T_TOK, 4096, 1024, e, 0);
        }
        xcd_barrier(bar);
        { WSPTRS
            EpiA e{}; e.mode = 0; e.xin_b = hb; e.xout_b = hb; e.ss_out = ssx + (size_t)(l * 3 + 2) * T_TOK * 16;
            run_gemm(lds, hid, 4096, (const bf16_t*)(wl + WL_W2), T_TOK, 1024, 4096, e, 0);
        }
        xcd_barrier(bar);
        if (l == 0) {
        } else { WSPTRS
            const float* gf = inp(P, 25); const float* ssf = ssx + (size_t)5 * T_TOK * 16;
            const int ngw = G * 8;
            f32x4 gg[4];
#pragma unroll
            for (int jq = 0; jq < 4; ++jq) gg[jq] = *(const f32x4*)(gf + 4 * lane + 256 * jq);
            int r = blockIdx.x * 8 + wave;
            for (; r + 3 * ngw < T_TOK; r += 4 * ngw) {
                float rstd[4]; u32x2 xv[4][4];
#pragma unroll
                for (int q = 0; q < 4; ++q) {
                    rstd[q] = rowstat16(ssf + (size_t)(r + q * ngw) * 16);
#pragma unroll
                    for (int jq = 0; jq < 4; ++jq) xv[q][jq] = *(const u32x2*)(hb + (size_t)(r + q * ngw) * 1024 + 4 * lane + 256 * jq);
                }
#pragma unroll
                for (int q = 0; q < 4; ++q) {
                    const float rs = rsqrtf(rstd[q] * (1.f / 1024.f) + EPS);
#pragma unroll
                    for (int jq = 0; jq < 4; ++jq) {
                        f32x4 y; y[0] = bflo(xv[q][jq].x) * rs * gg[jq][0]; y[1] = bfhi(xv[q][jq].x) * rs * gg[jq][1]; y[2] = bflo(xv[q][jq].y) * rs * gg[jq][2]; y[3] = bfhi(xv[q][jq].y) * rs * gg[jq][3];
                        *(f32x4*)(xres + (size_t)(r + q * ngw) * 1024 + 4 * lane + 256 * jq) = y;
                    }
                }
            }
            for (; r < T_TOK; r += ngw) {
                const float rs = rsqrtf(rowstat16(ssf + (size_t)r * 16) * (1.f / 1024.f) + EPS);
#pragma unroll
                for (int jq = 0; jq < 4; ++jq) {
                    const u32x2 xw = *(const u32x2*)(hb + (size_t)r * 1024 + 4 * lane + 256 * jq);
                    f32x4 y; y[0] = bflo(xw.x) * rs * gg[jq][0]; y[1] = bfhi(xw.x) * rs * gg[jq][1]; y[2] = bflo(xw.y) * rs * gg[jq][2]; y[3] = bfhi(xw.y) * rs * gg[jq][3];
                    *(f32x4*)(xres + (size_t)r * 1024 + 4 * lane + 256 * jq) = y;
                }
            }
        }
}

__global__ void __launch_bounds__(512, 2) fwd_megakernel(Params P) {
    extern __shared__ __attribute__((aligned(16))) unsigned char lds_raw[];
    LAS unsigned char* lds = (LAS unsigned char*)lds_raw;
    cg::grid_group grid = cg::this_grid();
    volatile LAS unsigned* bst = (volatile LAS unsigned*)(lds + 139264);
    if (threadIdx.x == 0) { bst[0] = 0u; bst[1] = 0u; }
    __syncthreads();
    const XcdBarrier bar = xcd_barrier_post((unsigned*)(wsp(P) + WS_CTL), bst);
    {
        PHASE_PRE
        unsigned char* ws = wsp(P); bf16_t* hb = (bf16_t*)(ws + R_H); const float* x_in = inp(P, 0); const float* mem = inp(P, 1);
        float* ssx = (float*)(ws + WS_SSX);
        LAS float* tile = (LAS float*)lds;
        for (int l = 0; l < 2; ++l) {
            unsigned char* wl = ws + WS_W + (size_t)l * WL_SIZE;
            const float* w_in = inp(P, 3) + (size_t)l * 1024 * 5812;
            transpose_job(w_in, 5812, 1024, 2816, 1, 0, (bf16_t*)(wl + WL_WIN), tile, tid, (0 + 144 * l) & 255, inp(P, 2) + l * 1024);
            transpose_job(w_in, 5812, 1024, 3072, 0, 2740, (bf16_t*)(wl + WL_WG), tile, tid, (80 + 144 * l) & 255, inp(P, 2) + l * 1024);
            transpose_job(inp(P, 13) + (size_t)l * 256 * 1024, 1024, 256, 1024, 0, 0, (bf16_t*)(wl + WL_UPF), tile, tid, (144 + 144 * l) & 255);
            transpose_job(inp(P, 14) + (size_t)l * 512 * 1024, 1024, 512, 1024, 0, 0, (bf16_t*)(wl + WL_UPG), tile, tid, (128 + 144 * l) & 255);
            transpose_job(inp(P, 15) + (size_t)l * 256 * 1024, 1024, 256, 1024, 0, 0, (bf16_t*)(wl + WL_UPM), tile, tid, (96 + 144 * l) & 255);
            transpose_job(inp(P, 16) + (size_t)l * 1024 * 1024, 1024, 1024, 1024, 0, 0, (bf16_t*)(wl + WL_OUT), tile, tid, (80 + 144 * l) & 255);
            transpose_job(inp(P, 19) + (size_t)l * 1024 * 512, 512, 1024, 512, 0, 0, (bf16_t*)(wl + WL_XQ), tile, tid, (16 + 144 * l) & 255, inp(P, 17) + l * 1024);
            transpose_job(inp(P, 20) + (size_t)l * 1024 * 1024, 1024, 1024, 1024, 0, 0, (bf16_t*)(wl + WL_XKV), tile, tid, (240 + 144 * l) & 255);
            transpose_job(inp(P, 21) + (size_t)l * 512 * 1024, 1024, 512, 1024, 0, 0, (bf16_t*)(wl + WL_XO), tile, tid, (176 + 144 * l) & 255);
            transpose_job(inp(P, 23) + (size_t)l * 1024 * 4096, 4096, 1024, 4096, 0, 0, (bf16_t*)(wl + WL_W1), tile, tid, (144 + 144 * l) & 255, inp(P, 22) + l * 1024);
            transpose_job(inp(P, 24) + (size_t)l * 4096 * 1024, 1024, 4096, 1024, 0, 0, (bf16_t*)(wl + WL_W2), tile, tid, (144 + 144 * l) & 255);
            bf16_t* wm = (bf16_t*)(wl + WL_WM);
            const float* gq = inp(P, 8) + l * 256; const float* wuq = inp(P, 9) + (size_t)l * 256 * 384;
            const float* gkv = inp(P, 10) + l * 128; const float* wukv = inp(P, 11) + (size_t)l * 128 * 512;
            for (int i = blockIdx.x * 512 + tid; i < 1024 * 384; i += G * 512) {
                const int n = i / 384, k = i - n * 384; float v = 0.f;
                if (n < 384) { if (k < 256) v = gq[k] * wuq[(size_t)k * 384 + n]; }
                else if (n < 896) { if (k >= 256) v = gkv[k - 256] * wukv[(size_t)(k - 256) * 512 + (n - 384)]; }
                wm[i] = (bf16_t)(pk2(v, 0.f) & 0xffffu);
            }
            norm_phase(mem, inp(P, 18) + l * 1024, (bf16_t*)(ws + WS_MEMN) + (size_t)l * 2048 * 1024, nullptr, 2048, tid);
        }
        rawnorm_phase(x_in, hb, ssx + (size_t)6 * T_TOK * 16, T_TOK, tid);
    }
    grid.sync();

    layer_body<0>(P, lds, bar);
    layer_body<1>(P, lds, bar);
}

extern "C" void kernel_launch(void* const* d_in, const int* in_sizes, int n_in, void* d_out, int out_size, void* d_ws, size_t ws_size, hipStream_t stream) {
    static int grid_blocks = 0;
    if (grid_blocks == 0) {
        if (n_in != 26 || ws_size < WS_NEED) { fprintf(stderr, "kernel_launch: expected 26 inputs and >= %zu bytes of workspace (got %d, %zu)\n", (size_t)WS_NEED, n_in, ws_size); grid_blocks = -1; return; }
        int dev = 0, cus = 0, per_cu = 0;
        (void)hipGetDevice(&dev);
        (void)hipDeviceGetAttribute(&cus, hipDeviceAttributeMultiprocessorCount, dev);
        if (hipFuncSetAttribute((const void*)fwd_megakernel, hipFuncAttributeMaxDynamicSharedMemorySize, LDS_BYTES) != hipSuccess) { fprintf(stderr, "kernel_launch: hipFuncSetAttribute failed\n"); grid_blocks = -1; return; }
        if (hipOccupancyMaxActiveBlocksPerMultiprocessor(&per_cu, (const void*)fwd_megakernel, 512, LDS_BYTES) != hipSuccess || per_cu < 1) { fprintf(stderr, "kernel_launch: occupancy query gave %d\n", per_cu); per_cu = 1; }
        (void)hipGetLastError();
        grid_blocks = cus;
    }
    if (grid_blocks < 0) return;
    if (hipMemsetAsync(d_ws, 0, 65536, stream) != hipSuccess) { fprintf(stderr, "kernel_launch: hipMemsetAsync failed\n"); return; }
    Params p{};
    for (int i = 0; i < 26; ++i) p.p[i] = d_in[i];
    p.p[26] = d_out; p.p[27] = d_ws;
    void* args[] = {&p};
    hipError_t e = hipLaunchCooperativeKernel((const void*)fwd_megakernel, dim3(grid_blocks), dim3(512), args, LDS_BYTES, stream);
    if (e != hipSuccess) fprintf(stderr, "cooperative launch failed: %s (grid %d)\n", hipGetErrorString(e), grid_blocks);
}
```

```cpp
#include <hip/hip_runtime.h>
#include <hip/hip_cooperative_groups.h>
#include <cstdio>
#include <cstdint>
namespace cg = cooperative_groups;

#define LAS __attribute__((address_space(3)))
typedef unsigned short bf16_t;
typedef short bf16x8 __attribute__((ext_vector_type(8)));
typedef float f32x4 __attribute__((ext_vector_type(4)));
typedef float f32x2 __attribute__((ext_vector_type(2)));
typedef float f32x16 __attribute__((ext_vector_type(16)));
typedef unsigned u32x4 __attribute__((ext_vector_type(4)));
typedef unsigned u32x2 __attribute__((ext_vector_type(2)));
typedef __bf16 bf16x2n __attribute__((ext_vector_type(2)));

#define DI __device__ __forceinline__
DI unsigned pk2(float lo, float hi) { f32x2 f = {lo, hi}; bf16x2n b = __builtin_convertvector(f, bf16x2n); return __builtin_bit_cast(unsigned, b); }
DI float bf2f(unsigned short b) { return __uint_as_float(((unsigned)b) << 16); }
DI float bflo(unsigned w) { return __uint_as_float(w << 16); }
DI float bfhi(unsigned w) { return __uint_as_float(w & 0xffff0000u); }
DI void st4(bf16_t* p, f32x4 v) { u32x2 w; w.x = pk2(v[0], v[1]); w.y = pk2(v[2], v[3]); *(u32x2*)p = w; }
DI bf16x8 pack8(float a0, float a1, float a2, float a3, float a4, float a5, float a6, float a7) {
    u32x4 w; w.x = pk2(a0, a1); w.y = pk2(a2, a3); w.z = pk2(a4, a5); w.w = pk2(a6, a7); return __builtin_bit_cast(bf16x8, w);
}
#define MFMA32(a, b, c) __builtin_amdgcn_mfma_f32_32x32x16_bf16((a), (b), (c), 0, 0, 0)
DI int crow(int r, int hi) { return (r & 3) + 8 * (r >> 2) + 4 * hi; }

constexpr int T_TOK = 32768, SEQ = 4096, NBATCH = 8, DM = 1024, MEMLEN = 256;
constexpr int ZP = 2816;
constexpr int ZC_FQ = 0, ZC_FK = 256, ZC_FV = 512, ZC_GQ = 768, ZC_GK = 1024, ZC_GV = 1280, ZC_GR = 1792, ZC_MQ = 2304, ZC_MKV = 2560, ZC_MKR = 2688, ZC_FF = 2720, ZC_GLOW = 2736;
constexpr float LOG2E = 1.4426950408889634f;
constexpr float QS_FOX = 0.125f * LOG2E;
constexpr float QS_MLA = 0.10206207261596575f * LOG2E;
constexpr float QS_XA = 0.08838834764831845f * LOG2E;
constexpr float EPS = 1e-6f;

DI float logsig(float x) { return fminf(x, 0.f) - __logf(1.f + __expf(-fabsf(x))); }
DI float sigmoidf_(float x) { return __builtin_amdgcn_rcpf(1.f + __expf(-x)); }
DI float siluf_(float x) { return x * __builtin_amdgcn_rcpf(1.f + __expf(-x)); }
DI void rope_cs(int pos, int i, float& c, float& s) {
    const float inv = exp2f((float)i * (-13.287712379549449f / 16.0f));
    const float ang = (float)pos * inv;
    double rev = (double)ang * 0.15915494309189535;
    rev -= __builtin_rint(rev);
    const float rf = (float)rev;
    s = __builtin_amdgcn_sinf(rf); c = __builtin_amdgcn_cosf(rf);
}

namespace pg8 {
#define PG8_LAS __attribute__((address_space(3)))
constexpr int BM = 256, BK = 64, HALF = 128, HTB = HALF * BK * 2  , STAGE_BYTES = 8 * HTB, NXCD = 8, WGM = 8;
__host__ __device__ __forceinline__ int lds_byte(int r, int c) { const int st = (r >> 4) * 2 + (c >> 5), rr = r & 15, cc = c & 31, ob = rr * 64 + cc * 2; return st * 1024 + (ob ^ (((ob >> 9) & 1) << 5)); }
__host__ __device__ __forceinline__ void stage_rc(int b, int& R, int& C) { const int st = b / 1024, sb = b % 1024, swz = sb ^ (((sb >> 9) & 1) << 5); R = (st >> 1) * 16 + swz / 64; C = (st & 1) * 32 + (swz % 64) / 2; }
__host__ __device__ __forceinline__ int perm32(int rho) { const int n = rho >> 4, i = rho & 15; return 8 * (i >> 2) + 4 * n + (i & 3); }
struct Unit { int pm, pn; };
struct Gemm { const bf16_t* A; const bf16_t* Bt; int M, N, K, lda; };
struct StaticOrder {
    int nM, nN, nwg, G, c;
    __host__ __device__ void init(int M, int N, int G_, int c_) { nM = M / BM; nN = N / BM; nwg = nM * nN; G = G_; c = c_; }
    __host__ __device__ bool next(int i, Unit& u) const {
        const long L = (long)i * G + c; if (L >= nwg) return false;
        int wgid = (int)L; { const int q = nwg / NXCD, r = nwg % NXCD, xcd = wgid % NXCD, off = wgid / NXCD; wgid = (xcd < r ? xcd * (q + 1) : r * (q + 1) + (xcd - r) * q) + off; }
        const int nig = WGM * nN, gid = wgid / nig, fm = gid * WGM, gsz = (nM - fm) < WGM ? (nM - fm) : WGM;
        u.pm = fm + ((wgid % nig) % gsz); u.pn = (wgid % nig) / gsz; return true;
    }
    __device__ __forceinline__ void a_ready(const Unit&) const {}
    __device__ __forceinline__ void done(const Unit&) const {}
};
template <class Epi, class Sched, bool ALIGN_EPI = false, bool SP2 = false>
__device__ __forceinline__ void gemm_phase(PG8_LAS unsigned char* lds, const Gemm g, const Sched& S, const Epi& E) {
    int tid = threadIdx.x; asm volatile("" : "+v"(tid)); const int wid = __builtin_amdgcn_readfirstlane(tid >> 6), lane = tid & 63, wr = wid >> 2, wc = wid & 3, fr = lane & 15, fq = lane >> 4;
    const int K = g.K, nt = K / BK;
    unsigned voffA[2], voffB[2];
#pragma unroll
    for (int i = 0; i < 2; ++i) { int R, C; stage_rc(tid * 16 + i * 8192, R, C); const int Rb = Epi::PERM ? ((R & ~31) + perm32(R & 31)) : R;
        voffA[i] = (unsigned)(R * g.lda + C) * 2u; voffB[i] = (unsigned)(Rb * K + C) * 2u; }
    const size_t kstep = (size_t)(BK * 2);
    const size_t hstepA = (size_t)HALF * g.lda * 2, hstepB = (size_t)HALF * K * 2;
    const size_t tstepA = 2 * hstepA, tstepB = 2 * hstepB;
    const unsigned ldsw = (unsigned)wid * 1024u;
    const int aoff = lds_byte(wr * 64 + fr, fq * 8), boff = lds_byte(wc * 32 + fr, fq * 8);
#define PG8_SA(b, h) (((b) * 2 + (h)) * HTB)
#define PG8_SB(b, h) ((4 + (b) * 2 + (h)) * HTB)
#define PG8_STAGE(bufoff, gbase, voff) do { _Pragma("unroll") for (int _i = 0; _i < 2; ++_i) \
        __builtin_amdgcn_global_load_lds((const unsigned*)((const char*)(gbase) + (voff)[_i]), (PG8_LAS unsigned*)(lds + (bufoff) + ldsw + _i * 8192), 16, 0, 0); } while (0)
#define PG8_LDA(dst, b, h) do { _Pragma("unroll") for (int m = 0; m < 4; ++m) _Pragma("unroll") for (int k = 0; k < 2; ++k) dst[m][k] = *(const PG8_LAS bf16x8*)(lds + PG8_SA(b, h) + aoff + m * 2048 + k * 1024); } while (0)
#define PG8_LDB(dst, b, h) do { _Pragma("unroll") for (int n = 0; n < 2; ++n) _Pragma("unroll") for (int k = 0; k < 2; ++k) dst[n][k] = *(const PG8_LAS bf16x8*)(lds + PG8_SB(b, h) + boff + n * 2048 + k * 1024); } while (0)
#define PG8_MMA(ai, bj, At, Bt) do { __builtin_amdgcn_s_setprio(1); _Pragma("unroll") for (int m = 0; m < 4; ++m) _Pragma("unroll") for (int n = 0; n < 2; ++n) _Pragma("unroll") for (int k = 0; k < 2; ++k) \
        acc[ai][bj][m][n] = __builtin_amdgcn_mfma_f32_16x16x32_bf16(Bt[n][k], At[m][k], acc[ai][bj][m][n], 0, 0, 0); __builtin_amdgcn_s_setprio(0); } while (0)
#define PG8_WAIT_V(n) asm volatile("s_waitcnt vmcnt(" #n ")" ::: "memory")
#define PG8_WAIT_L(n) asm volatile("s_waitcnt lgkmcnt(" #n ")" ::: "memory")
#define PG8_BAR __builtin_amdgcn_s_barrier()
#define PG8_SCHED __builtin_amdgcn_sched_barrier(0)
    Unit cur, nxt; int ui = 0;
    if (!S.next(0, cur)) return;
    f32x4 acc[2][2][4][2];
#pragma unroll
    for (int a = 0; a < 2; ++a)
#pragma unroll
        for (int b = 0; b < 2; ++b)
#pragma unroll
            for (int m = 0; m < 4; ++m)
#pragma unroll
                for (int n = 0; n < 2; ++n) acc[a][b][m][n] = (f32x4){0.f, 0.f, 0.f, 0.f};
    bf16x8 At[4][2], B0[2][2], B1[2][2];
    const char* cA = (const char*)g.A + (size_t)cur.pm * tstepA; const char* cB = (const char*)g.Bt + (size_t)cur.pn * tstepB;
    S.a_ready(cur);
    if constexpr (SP2) {
        PG8_STAGE(PG8_SB(0, 0), cB, voffB); PG8_STAGE(PG8_SB(0, 1), cB + hstepB, voffB); PG8_STAGE(PG8_SA(0, 0), cA, voffA); PG8_STAGE(PG8_SA(0, 1), cA + hstepA, voffA);
        if (wr == 1) PG8_BAR;
        PG8_WAIT_V(2); PG8_BAR;
        PG8_STAGE(PG8_SB(1, 0), cB + kstep, voffB); PG8_STAGE(PG8_SA(1, 0), cA + kstep, voffA); PG8_STAGE(PG8_SB(1, 1), cB + hstepB + kstep, voffB);
        PG8_WAIT_V(6); PG8_BAR;
    } else {
        PG8_STAGE(PG8_SB(0, 0), cB, voffB); PG8_STAGE(PG8_SA(0, 0), cA, voffA); PG8_STAGE(PG8_SB(0, 1), cB + hstepB, voffB); PG8_STAGE(PG8_SA(0, 1), cA + hstepA, voffA);
        if (wr == 1) PG8_BAR;
        PG8_WAIT_V(4); PG8_BAR;
        PG8_STAGE(PG8_SB(1, 0), cB + kstep, voffB); PG8_STAGE(PG8_SA(1, 0), cA + kstep, voffA); PG8_STAGE(PG8_SB(1, 1), cB + hstepB + kstep, voffB);
        PG8_WAIT_V(6); PG8_BAR;
    }
    for (;;) {
        const bool has_next = S.next(ui + 1, nxt);
        const char* nA = has_next ? (const char*)g.A + (size_t)nxt.pm * tstepA : cA; const char* nB = has_next ? (const char*)g.Bt + (size_t)nxt.pn * tstepB : cB;
        for (int t = 0; t < nt; t += 2) {
            const bool last = (t == nt - 2);
            const char* a1 = cA + (size_t)(t + 1) * kstep;
            const char* a2 = last ? nA : cA + (size_t)(t + 2) * kstep; const char* b2 = last ? nB : cB + (size_t)(t + 2) * kstep;
            const char* a3 = a2 + kstep; const char* b3 = b2 + kstep;
            if (last && has_next) S.a_ready(nxt);
            if constexpr (SP2) {
            PG8_LDB(B0, 0, 0); PG8_LDB(B1, 0, 1); PG8_SCHED; PG8_LDA(At, 0, 0); PG8_STAGE(PG8_SA(1, 1), a1 + hstepA, voffA);
            PG8_WAIT_V(8); PG8_WAIT_L(0); PG8_BAR; PG8_MMA(0, 0, At, B0); PG8_MMA(0, 1, At, B1); PG8_BAR; PG8_SCHED;
            PG8_LDA(At, 0, 1); PG8_STAGE(PG8_SB(0, 0), b2, voffB); PG8_STAGE(PG8_SB(0, 1), b2 + hstepB, voffB); PG8_STAGE(PG8_SA(0, 0), a2, voffA);
            PG8_WAIT_V(8); PG8_WAIT_L(0); PG8_BAR; PG8_MMA(1, 0, At, B0); PG8_MMA(1, 1, At, B1); PG8_BAR; PG8_SCHED;
            PG8_LDB(B0, 1, 0); PG8_LDB(B1, 1, 1); PG8_SCHED; PG8_LDA(At, 1, 0); PG8_STAGE(PG8_SA(0, 1), a2 + hstepA, voffA);
            PG8_WAIT_V(8); PG8_WAIT_L(0); PG8_BAR; PG8_MMA(0, 0, At, B0); PG8_MMA(0, 1, At, B1); PG8_BAR; PG8_SCHED;
            PG8_LDA(At, 1, 1); PG8_STAGE(PG8_SB(1, 0), b3, voffB); PG8_STAGE(PG8_SB(1, 1), b3 + hstepB, voffB); PG8_STAGE(PG8_SA(1, 0), a3, voffA);
            PG8_WAIT_V(8); PG8_WAIT_L(0); PG8_BAR; PG8_MMA(1, 0, At, B0); PG8_MMA(1, 1, At, B1); PG8_BAR; PG8_SCHED;
            } else {
            PG8_LDB(B0, 0, 0); PG8_SCHED; PG8_LDA(At, 0, 0); PG8_STAGE(PG8_SA(1, 1), a1 + hstepA, voffA);
            PG8_WAIT_L(8); PG8_BAR; PG8_WAIT_L(0); PG8_MMA(0, 0, At, B0); PG8_BAR; PG8_SCHED;
            PG8_LDB(B1, 0, 1); PG8_STAGE(PG8_SB(0, 0), b2, voffB);
            PG8_BAR; PG8_WAIT_L(0); PG8_MMA(0, 1, At, B1); PG8_BAR;
            PG8_LDA(At, 0, 1); PG8_STAGE(PG8_SA(0, 0), a2, voffA);
            PG8_BAR; PG8_WAIT_L(0); PG8_MMA(1, 0, At, B0); PG8_BAR; PG8_SCHED;
            PG8_STAGE(PG8_SB(0, 1), b2 + hstepB, voffB);
            PG8_WAIT_V(6); PG8_BAR; PG8_MMA(1, 1, At, B1); PG8_BAR;
            PG8_LDB(B0, 1, 0); PG8_SCHED; PG8_LDA(At, 1, 0); PG8_STAGE(PG8_SA(0, 1), a2 + hstepA, voffA);
            PG8_WAIT_L(8); PG8_BAR; PG8_WAIT_L(0); PG8_MMA(0, 0, At, B0); PG8_BAR; PG8_SCHED;
            PG8_LDB(B1, 1, 1); PG8_STAGE(PG8_SB(1, 0), b3, voffB);
            PG8_BAR; PG8_WAIT_L(0); PG8_MMA(0, 1, At, B1); PG8_BAR;
            PG8_LDA(At, 1, 1); PG8_STAGE(PG8_SA(1, 0), a3, voffA);
            PG8_BAR; PG8_WAIT_L(0); PG8_MMA(1, 0, At, B0); PG8_BAR; PG8_SCHED;
            PG8_STAGE(PG8_SB(1, 1), b3 + hstepB, voffB);
            PG8_WAIT_V(6); PG8_BAR; PG8_MMA(1, 1, At, B1); PG8_BAR;
            }
        }
        if constexpr (ALIGN_EPI) { if (wr == 0) PG8_BAR; }
        if constexpr (!Epi::AFTER_DRAIN) { E(acc, cur, wr, wc, fr, fq); S.done(cur); }
        if (!has_next) break;
#pragma unroll
        for (int a = 0; a < 2; ++a)
#pragma unroll
            for (int b = 0; b < 2; ++b)
#pragma unroll
                for (int m = 0; m < 4; ++m)
#pragma unroll
                    for (int n = 0; n < 2; ++n) acc[a][b][m][n] = (f32x4){0.f, 0.f, 0.f, 0.f};
        cur = nxt; cA = nA; cB = nB; ++ui;
        if constexpr (ALIGN_EPI) { if (wr == 1) PG8_BAR; }
    }
    PG8_WAIT_V(0);
    if constexpr (!ALIGN_EPI) { if (wr == 0) PG8_BAR; }
    PG8_BAR;
    if constexpr (Epi::AFTER_DRAIN) { E.fused(acc, cur, wr, wc, fr, fq, lds, wid, lane); S.done(cur); }
#undef PG8_SA
#undef PG8_SB
#undef PG8_STAGE
#undef PG8_LDA
#undef PG8_LDB
#undef PG8_MMA
#undef PG8_WAIT_V
#undef PG8_WAIT_L
#undef PG8_BAR
#undef PG8_SCHED
}
}

DI float rowstat16(const float* p) {
    const f32x4 a = *(const f32x4*)p, b = *(const f32x4*)(p + 4), c = *(const f32x4*)(p + 8), d = *(const f32x4*)(p + 12);
    return (((a[0] + a[1]) + (a[2] + a[3])) + ((b[0] + b[1]) + (b[2] + b[3]))) + (((c[0] + c[1]) + (c[2] + c[3])) + ((d[0] + d[1]) + (d[2] + d[3])));
}
#define EPI_FENCE() do { asm volatile("" ::: "memory"); __builtin_amdgcn_sched_barrier(0); } while (0)
DI void rope8(f32x4& v0, f32x4& v1, const int pos, const int fq) {
    float own[8] = {v0[0], v0[1], v0[2], v0[3], v1[0], v1[1], v1[2], v1[3]}, oth[8];
#pragma unroll
    for (int t = 0; t < 8; ++t) oth[t] = __shfl_xor(own[t], 32);
    const bool first = fq < 2; const int ib = 8 * (fq & 1);
#pragma unroll
    for (int t = 0; t < 8; ++t) { float c, s; rope_cs(pos, ib + t, c, s); own[t] = first ? (own[t] * c - oth[t] * s) : (own[t] * c + oth[t] * s); }
    v0 = (f32x4){own[0], own[1], own[2], own[3]}; v1 = (f32x4){own[4], own[5], own[6], own[7]};
}
DI void st8(bf16_t* p, const f32x4& v0, const f32x4& v1) { u32x4 w; w.x = pk2(v0[0], v0[1]); w.y = pk2(v0[2], v0[3]); w.z = pk2(v1[0], v1[1]); w.w = pk2(v1[2], v1[3]); *(u32x4*)p = w; }
struct EpiA {
    static constexpr bool PERM = true, AFTER_DRAIN = false;
    int mode;
    const bf16_t* xin_b; bf16_t* xout_b; float* ss_out;
    const float* rs_in;
    bf16_t* z; float* lf; float* ssq; const float* bfox;
    bf16_t* qh; bf16_t* kvb;
    __device__ __forceinline__ void operator()(const f32x4 (&acc)[2][2][4][2], const pg8::Unit& u, int wr, int wc, int fr, int fq) const {
        const int rbase = u.pm * 256 + wr * 64 + fr;
        const int colb = u.pn * 256 + wc * 32 + 8 * fq;
        if (mode == 0) {
#pragma unroll
            for (int ai = 0; ai < 2; ++ai) {
                u32x4 xo[4][2];
#pragma unroll
                for (int m = 0; m < 4; ++m)
#pragma unroll
                    for (int bj = 0; bj < 2; ++bj) xo[m][bj] = *(const u32x4*)(xin_b + (size_t)(rbase + ai * 128 + m * 16) * 1024 + colb + bj * 128);
                EPI_FENCE();
#pragma unroll
                for (int m = 0; m < 4; ++m) {
                    const int row = rbase + ai * 128 + m * 16;
                    float ss = 0.f;
#pragma unroll
                    for (int bj = 0; bj < 2; ++bj) {
                        const u32x4 x = xo[m][bj];
                        f32x4 v0 = acc[ai][bj][m][0], v1 = acc[ai][bj][m][1];
                        v0[0] += bflo(x.x); v0[1] += bfhi(x.x); v0[2] += bflo(x.y); v0[3] += bfhi(x.y); v1[0] += bflo(x.z); v1[1] += bfhi(x.z); v1[2] += bflo(x.w); v1[3] += bfhi(x.w);
                        u32x4 w; w.x = pk2(v0[0], v0[1]); w.y = pk2(v0[2], v0[3]); w.z = pk2(v1[0], v1[1]); w.w = pk2(v1[2], v1[3]);
                        *(u32x4*)(xout_b + (size_t)row * 1024 + colb + bj * 128) = w;
                        const float r0 = bflo(w.x), r1 = bfhi(w.x), r2 = bflo(w.y), r3 = bfhi(w.y), r4 = bflo(w.z), r5 = bfhi(w.z), r6 = bflo(w.w), r7 = bfhi(w.w);
                        ss += ((r0 * r0 + r1 * r1) + (r2 * r2 + r3 * r3)) + ((r4 * r4 + r5 * r5) + (r6 * r6 + r7 * r7));
                    }
                    ss += __shfl_xor(ss, 16); ss += __shfl_xor(ss, 32);
                    if (fq == 0) ss_out[(size_t)row * 16 + u.pn * 4 + wc] = ss;
                }
                EPI_FENCE();
            }
        } else if (mode == 1) {
            const int pn = u.pn;
#pragma unroll
            for (int ai = 0; ai < 2; ++ai) {
                float rs4[4];
#pragma unroll
                for (int m = 0; m < 4; ++m) rs4[m] = rsqrtf(rowstat16(rs_in + (size_t)(rbase + ai * 128 + m * 16) * 16) * (1.f / 1024.f) + EPS);
                EPI_FENCE();
                if (pn < 10) {
#pragma unroll
                    for (int m = 0; m < 4; ++m) {
                        const int row = rbase + ai * 128 + m * 16;
                        const float rs = rs4[m];
                        float ss = 0.f;
#pragma unroll
                        for (int bj = 0; bj < 2; ++bj) {
                            f32x4 v0 = acc[ai][bj][m][0] * rs, v1 = acc[ai][bj][m][1] * rs;
                            if (pn == 0) { v0 = v0 * QS_FOX; v1 = v1 * QS_FOX; }
                            else if (pn == 7 || pn == 8) {
#pragma unroll
                                for (int j = 0; j < 4; ++j) { v0[j] = siluf_(v0[j]); v1[j] = siluf_(v1[j]); }
                            } else if (pn == 9) ss += ((v0[0] * v0[0] + v0[1] * v0[1]) + (v0[2] * v0[2] + v0[3] * v0[3])) + ((v1[0] * v1[0] + v1[1] * v1[1]) + (v1[2] * v1[2] + v1[3] * v1[3]));
                            st8(z + (size_t)row * ZP + colb + bj * 128, v0, v1);
                        }
                        if (pn == 9) { ss += __shfl_xor(ss, 16); ss += __shfl_xor(ss, 32); if (fq == 0) ssq[(size_t)row * 8 + wc] = ss; }
                    }
                } else {
#pragma unroll
                    for (int m = 0; m < 4; ++m) {
                        const int row = rbase + ai * 128 + m * 16;
                        const int pos = row & (SEQ - 1);
                        bf16_t* zr = z + (size_t)row * ZP + 2560;
                        const float rs = rs4[m];
                        {
                            const f32x4 v0 = acc[ai][0][m][0] * rs, v1 = acc[ai][0][m][1] * rs;
                            float ss = ((v0[0] * v0[0] + v0[1] * v0[1]) + (v0[2] * v0[2] + v0[3] * v0[3])) + ((v1[0] * v1[0] + v1[1] * v1[1]) + (v1[2] * v1[2] + v1[3] * v1[3]));
                            st8(zr + wc * 32 + 8 * fq, v0, v1);
                            ss += __shfl_xor(ss, 16); ss += __shfl_xor(ss, 32);
                            if (fq == 0) ssq[(size_t)row * 8 + 4 + wc] = ss;
                        }
                        if (wc == 0) {
                            f32x4 v0 = acc[ai][1][m][0] * rs, v1 = acc[ai][1][m][1] * rs;
                            rope8(v0, v1, pos, fq);
                            st8(zr + 128 + 8 * fq, v0, v1);
                        } else if (wc == 1) {
                            if (fq == 0) { f32x4 v = acc[ai][1][m][0] * rs;
#pragma unroll
                                for (int j = 0; j < 4; ++j) v[j] = logsig(v[j] + bfox[j]) * LOG2E;
                                *(f32x4*)(lf + (size_t)row * 4) = v; }
                            if (fq >= 2) st8(zr + 160 + 8 * fq, acc[ai][1][m][0] * rs, acc[ai][1][m][1] * rs);
                        }
                        EPI_FENCE();
                    }
                }
                EPI_FENCE();
            }
        } else {
#pragma unroll
            for (int ai = 0; ai < 2; ++ai) {
                float rq4[4], rkv4[4];
#pragma unroll
                for (int m = 0; m < 4; ++m) {
                    const float* sp = ssq + (size_t)(rbase + ai * 128 + m * 16) * 8;
                    const f32x4 pq = *(const f32x4*)sp, pk = *(const f32x4*)(sp + 4);
                    rq4[m] = rsqrtf(((pq[0] + pq[1]) + (pq[2] + pq[3])) * (1.f / 256.f) + EPS) * QS_MLA;
                    rkv4[m] = rsqrtf(((pk[0] + pk[1]) + (pk[2] + pk[3])) * (1.f / 128.f) + EPS);
                }
                EPI_FENCE();
#pragma unroll
                for (int m = 0; m < 4; ++m) {
                    const int row = rbase + ai * 128 + m * 16;
                    const int pos = row & (SEQ - 1);
                    const float rq = rq4[m], rkv = rkv4[m];
#pragma unroll
                    for (int bj = 0; bj < 2; ++bj) {
                        const int G = u.pn * 8 + bj * 4 + wc;
                        if (G < 12) {
                            const int head = G / 3, part = G - 3 * head;
                            f32x4 v0 = acc[ai][bj][m][0] * rq, v1 = acc[ai][bj][m][1] * rq;
                            if (part == 2) rope8(v0, v1, pos, fq);
                            st8(qh + (size_t)row * 384 + head * 96 + part * 32 + 8 * fq, v0, v1);
                        } else if (G < 28) {
                            st8(kvb + (size_t)row * 512 + (G - 12) * 32 + 8 * fq, acc[ai][bj][m][0] * rkv, acc[ai][bj][m][1] * rkv);
                        }
                    }
                    EPI_FENCE();
                }
            }
        }
    }
};
struct EpiB {
    static constexpr bool PERM = true, AFTER_DRAIN = false;
    int mode; bf16_t* out; int ldc; float scale; const float* bias; const bf16_t* gate; int first; const float* rs_in;
    __device__ __forceinline__ void operator()(const f32x4 (&acc)[2][2][4][2], const pg8::Unit& u, int wr, int wc, int fr, int fq) const {
        const int rbase = u.pm * 256 + wr * 64 + fr;
        const int colb = u.pn * 256 + wc * 32 + 8 * fq;
        if (mode == 3) {
#pragma unroll
            for (int ai = 0; ai < 2; ++ai) {
                u32x4 g4[4][2], y4[4][2];
#pragma unroll
                for (int m = 0; m < 4; ++m)
#pragma unroll
                    for (int bj = 0; bj < 2; ++bj) {
                        const size_t off = (size_t)(rbase + ai * 128 + m * 16) * ldc + colb + bj * 128;
                        g4[m][bj] = *(const u32x4*)(gate + off);
                        if (!first) y4[m][bj] = *(const u32x4*)(out + off); else y4[m][bj] = (u32x4){0u, 0u, 0u, 0u};
                    }
                EPI_FENCE();
#pragma unroll
                for (int m = 0; m < 4; ++m)
#pragma unroll
                    for (int bj = 0; bj < 2; ++bj) {
                        const size_t off = (size_t)(rbase + ai * 128 + m * 16) * ldc + colb + bj * 128;
                        const u32x4 g = g4[m][bj], y = y4[m][bj];
                        f32x4 v0 = acc[ai][bj][m][0], v1 = acc[ai][bj][m][1];
                        v0[0] = v0[0] * bflo(g.x) + bflo(y.x); v0[1] = v0[1] * bfhi(g.x) + bfhi(y.x); v0[2] = v0[2] * bflo(g.y) + bflo(y.y); v0[3] = v0[3] * bfhi(g.y) + bfhi(y.y);
                        v1[0] = v1[0] * bflo(g.z) + bflo(y.z); v1[1] = v1[1] * bfhi(g.z) + bfhi(y.z); v1[2] = v1[2] * bflo(g.w) + bflo(y.w); v1[3] = v1[3] * bfhi(g.w) + bfhi(y.w);
                        u32x4 w; w.x = pk2(v0[0], v0[1]); w.y = pk2(v0[2], v0[3]); w.z = pk2(v1[0], v1[1]); w.w = pk2(v1[2], v1[3]);
                        *(u32x4*)(out + off) = w;
                    }
                EPI_FENCE();
            }
            return;
        }
#pragma unroll
        for (int ai = 0; ai < 2; ++ai) {
            float rs4[4];
#pragma unroll
            for (int m = 0; m < 4; ++m) rs4[m] = rs_in ? rsqrtf(rowstat16(rs_in + (size_t)(rbase + ai * 128 + m * 16) * 16) * (1.f / 1024.f) + EPS) : 1.f;
            EPI_FENCE();
#pragma unroll
            for (int m = 0; m < 4; ++m) {
                const int row = rbase + ai * 128 + m * 16;
                const float rs = rs4[m];
#pragma unroll
                for (int bj = 0; bj < 2; ++bj) {
                    const int col = colb + bj * 128;
                    const size_t off = (size_t)row * ldc + col;
                    f32x4 v0 = acc[ai][bj][m][0] * rs, v1 = acc[ai][bj][m][1] * rs;
                    if (mode == 0) { v0 = v0 * scale; v1 = v1 * scale; }
                    else if (mode == 1) {
#pragma unroll
                        for (int j = 0; j < 4; ++j) { const float a = fmaxf(v0[j], 0.f), b = fmaxf(v1[j], 0.f); v0[j] = a * a; v1[j] = b * b; }
                    } else {
                        const f32x4 b0 = *(const f32x4*)(bias + col), b1 = *(const f32x4*)(bias + col + 4);
#pragma unroll
                        for (int j = 0; j < 4; ++j) { v0[j] = sigmoidf_(v0[j] + b0[j]); v1[j] = sigmoidf_(v1[j] + b1[j]); }
                    }
                    u32x4 w; w.x = pk2(v0[0], v0[1]); w.y = pk2(v0[2], v0[3]); w.z = pk2(v1[0], v1[1]); w.w = pk2(v1[2], v1[3]);
                    *(u32x4*)(out + off) = w;
                }
            }
            EPI_FENCE();
        }
    }
};

template <class Epi>
DI void run_gemm(LAS unsigned char* lds, const bf16_t* A, int lda, const bf16_t* Bt, int M, int N, int K, const Epi& E, int cshift) {
    pg8::Gemm g; g.A = A; g.Bt = Bt; g.M = M; g.N = N; g.K = K; g.lda = lda;
    pg8::StaticOrder so; so.init(M, N, (int)gridDim.x, (int)((blockIdx.x + cshift) % gridDim.x));
    pg8::gemm_phase<Epi, pg8::StaticOrder, true, true>(lds, g, so, E);
}

struct AttnP {
    const bf16_t* q; int qp;
    const bf16_t* k1; int k1p; const bf16_t* k2; int k2p;
    const bf16_t* v; int vp;
    bf16_t* o; int op;
    const float* bias;
    float kmax;
};
#define ATT_BAR() do { asm volatile("s_waitcnt lgkmcnt(0)" ::: "memory"); __builtin_amdgcn_s_barrier(); asm volatile("" ::: "memory"); } while (0)
template <int DK, int DV, int MODE, int VP = 68>
DI void attn_tile(const LAS unsigned char* kbuf, const LAS unsigned char* vbuf, const LAS float* cb, const int j, const int q0w, const int qrow, const int l32, const int hi, const float cq,
                  const bf16x8 (&qf)[DK / 16], f32x16 (&o)[DV / 32], float& mrun, float& lrun) {
    constexpr int KP = DK + 8;
    f32x16 s0, s1;
#pragma unroll
    for (int r = 0; r < 16; ++r) { s0[r] = 0.f; s1[r] = 0.f; }
    const LAS unsigned char* kb = kbuf + (l32 * KP + 8 * hi) * 2;
    const LAS unsigned char* vb = vbuf + (l32 * VP + 4 * hi) * 2;
    constexpr int KCHK = 2;
#pragma unroll
    for (int c0 = 0; c0 < DK / 16; c0 += KCHK) {
        bf16x8 ka[2][KCHK];
#pragma unroll
        for (int ds = 0; ds < KCHK; ++ds) { ka[0][ds] = *(const LAS bf16x8*)(kb + (c0 + ds) * 32); ka[1][ds] = *(const LAS bf16x8*)(kb + 32 * KP * 2 + (c0 + ds) * 32); }
#pragma unroll
        for (int ds = 0; ds < KCHK; ++ds) { s0 = MFMA32(ka[0][ds], qf[c0 + ds], s0); s1 = MFMA32(ka[1][ds], qf[c0 + ds], s1); }
    }
    if (MODE == 0) {
#pragma unroll
        for (int rq = 0; rq < 4; ++rq) {
            const f32x4 c0 = *(const LAS f32x4*)(cb + 8 * rq + 4 * hi), c1 = *(const LAS f32x4*)(cb + 32 + 8 * rq + 4 * hi);
#pragma unroll
            for (int jj = 0; jj < 4; ++jj) { s0[4 * rq + jj] += cq - c0[jj]; s1[4 * rq + jj] += cq - c1[jj]; }
        }
        if (64 * j + 63 > q0w) {
#pragma unroll
            for (int r = 0; r < 16; ++r) { const int kv = 64 * j + crow(r, hi); if (kv > qrow) s0[r] = -__builtin_inff(); if (kv + 32 > qrow) s1[r] = -__builtin_inff(); }
        }
    }
    float mx = fmaxf(s0[0], s1[0]);
#pragma unroll
    for (int r = 1; r < 16; ++r) mx = fmaxf(mx, fmaxf(s0[r], s1[r]));
    mx = fmaxf(mx, __shfl_xor(mx, 32));
    const float mn = fmaxf(mrun, mx);
    const float alpha = __builtin_amdgcn_exp2f(mrun - mn);
    mrun = mn;
    float ls = 0.f;
#pragma unroll
    for (int r = 0; r < 16; ++r) { s0[r] = __builtin_amdgcn_exp2f(s0[r] - mn); s1[r] = __builtin_amdgcn_exp2f(s1[r] - mn); ls += s0[r] + s1[r]; }
    lrun = lrun * alpha + ls;
#pragma unroll
    for (int i = 0; i < DV / 32; ++i)
#pragma unroll
        for (int r = 0; r < 16; ++r) o[i][r] *= alpha;
    bf16x8 pf[4];
    pf[0] = pack8(s0[0], s0[1], s0[2], s0[3], s0[4], s0[5], s0[6], s0[7]);
    pf[1] = pack8(s0[8], s0[9], s0[10], s0[11], s0[12], s0[13], s0[14], s0[15]);
    pf[2] = pack8(s1[0], s1[1], s1[2], s1[3], s1[4], s1[5], s1[6], s1[7]);
    pf[3] = pack8(s1[8], s1[9], s1[10], s1[11], s1[12], s1[13], s1[14], s1[15]);
#pragma unroll
    for (int dvp = 0; dvp < DV / 32; ++dvp) {
        u32x2 wlo[4], whi[4];
#pragma unroll
        for (int f = 0; f < 4; ++f) {
            const int off = dvp * 32 * VP * 2 + (32 * (f >> 1) + 16 * (f & 1)) * 2;
            wlo[f] = *(const LAS u32x2*)(vb + off); whi[f] = *(const LAS u32x2*)(vb + off + 16);
        }
#pragma unroll
        for (int f = 0; f < 4; ++f) {
            u32x4 av; av.x = wlo[f].x; av.y = wlo[f].y; av.z = whi[f].x; av.w = whi[f].y;
            o[dvp] = MFMA32(__builtin_bit_cast(bf16x8, av), pf[f], o[dvp]);
        }
    }
}

template <int DK, int DV, int MODE, int K1C>
DI void attn_unit(LAS unsigned char* lds, const AttnP& a, const int q0, const int tid_in) {
    int tid = tid_in; asm volatile("" : "+v"(tid));
    constexpr int KP = DK + 8, VP = 68;
    constexpr int KBYTES = 64 * KP * 2, VBYTES = DV * VP * 2;
    constexpr int KCH = DK / 8, NKC = 64 * KCH, KPT = (NKC + 511) / 512;
    constexpr int VCH = DV / 8, NVT = 32 * VCH;
    LAS unsigned char* Kb = lds; LAS unsigned char* Vb = lds + 2 * KBYTES; LAS float* Cb = (LAS float*)(lds + 2 * KBYTES + 2 * VBYTES);
    const int wave = tid >> 6, lane = tid & 63, l32 = lane & 31, hi = lane >> 5;
    const int q0w = q0 + 32 * wave, qrow = q0w + l32;
    int ntiles, wtiles;
    if (MODE == 2) { ntiles = 4; wtiles = 4; }
    else { ntiles = (q0 + 256) / 64; wtiles = (MODE == 0) ? ((q0w + 31) / 64 + 1) : (q0w / 64 + 1); }
    bf16x8 qf[DK / 16];
#pragma unroll
    for (int ds = 0; ds < DK / 16; ++ds) qf[ds] = *(const bf16x8*)(a.q + (size_t)qrow * a.qp + ds * 16 + 8 * hi);
    float cq = 0.f; if (MODE == 0) cq = a.bias[qrow];
    f32x16 o[DV / 32];
#pragma unroll
    for (int i = 0; i < DV / 32; ++i)
#pragma unroll
        for (int r = 0; r < 16; ++r) o[i][r] = 0.f;
    float mrun = -__builtin_inff(), lrun = 0.f;
    u32x4 krA[KPT], krB[KPT]; u32x4 vrA0 = {0, 0, 0, 0}, vrA1 = {0, 0, 0, 0}, vrB0 = {0, 0, 0, 0}, vrB1 = {0, 0, 0, 0}; float crA = 0.f, crB = 0.f;
    const int vkvp = tid / VCH, vdvg = tid % VCH;
#define ATT_GLOAD(S, J) do { \
        _Pragma("unroll") for (int p_ = 0; p_ < KPT; ++p_) { const int ci_ = tid + 512 * p_; if (ci_ < NKC) { const int row_ = ci_ / KCH, cc_ = ci_ % KCH; \
            const bf16_t* src_ = (cc_ < K1C) ? (a.k1 + (size_t)(64 * (J) + row_) * a.k1p + cc_ * 8) : (a.k2 + (size_t)(64 * (J) + row_) * a.k2p + (cc_ - K1C) * 8); \
            kr##S[p_] = *(const u32x4*)src_; } } \
        if (tid < NVT) { const bf16_t* vs_ = a.v + (size_t)(64 * (J) + 2 * vkvp) * a.vp + vdvg * 8; vr##S##0 = *(const u32x4*)vs_; vr##S##1 = *(const u32x4*)(vs_ + a.vp); } \
        if (MODE == 0 && tid < 64) cr##S = a.bias[64 * (J) + tid]; } while (0)
#define ATT_LWRITE(S, B) do { \
        _Pragma("unroll") for (int p_ = 0; p_ < KPT; ++p_) { const int ci_ = tid + 512 * p_; if (ci_ < NKC) { const int row_ = ci_ / KCH, cc_ = ci_ % KCH; \
            *(LAS u32x4*)(Kb + (B) * KBYTES + (row_ * KP + cc_ * 8) * 2) = kr##S[p_]; } } \
        if (tid < NVT) { LAS unsigned char* vd_ = Vb + (B) * VBYTES + ((vdvg * 8) * VP + 2 * vkvp) * 2; \
            _Pragma("unroll") for (int w_ = 0; w_ < 4; ++w_) { \
                *(LAS unsigned*)(vd_ + (2 * w_) * VP * 2) = (vr##S##0[w_] & 0xffffu) | (vr##S##1[w_] << 16); \
                *(LAS unsigned*)(vd_ + (2 * w_ + 1) * VP * 2) = (vr##S##0[w_] >> 16) | (vr##S##1[w_] & 0xffff0000u); } } \
        if (MODE == 0 && tid < 64) Cb[(B) * 64 + tid] = cr##S; } while (0)
    ATT_GLOAD(A, 0);
    ATT_GLOAD(B, 1);
    ATT_LWRITE(A, 0);
    ATT_GLOAD(A, 2);
    for (int j = 0; j < ntiles; j += 2) {
        __syncthreads();
        if (j < wtiles) attn_tile<DK, DV, MODE>(Kb, Vb, Cb, j, q0w, qrow, l32, hi, cq, qf, o, mrun, lrun);
        ATT_LWRITE(B, 1);
        if (j + 3 < ntiles) ATT_GLOAD(B, j + 3);
        __syncthreads();
        if (j + 1 < wtiles) attn_tile<DK, DV, MODE>(Kb + KBYTES, Vb + VBYTES, Cb + 64, j + 1, q0w, qrow, l32, hi, cq, qf, o, mrun, lrun);
        if (j + 2 < ntiles) { ATT_LWRITE(A, 0); if (j + 4 < ntiles) ATT_GLOAD(A, j + 4); }
    }
    __syncthreads();
#undef ATT_GLOAD
#undef ATT_LWRITE
    const float lt = lrun + __shfl_xor(lrun, 32);
    const float inv = 1.0f / lt;
    bf16_t* orow = a.o + (size_t)qrow * a.op + 4 * hi;
#pragma unroll
    for (int dvh = 0; dvh < DV / 32; ++dvh)
#pragma unroll
        for (int rq = 0; rq < 4; ++rq) {
            f32x4 v; v[0] = o[dvh][4 * rq] * inv; v[1] = o[dvh][4 * rq + 1] * inv; v[2] = o[dvh][4 * rq + 2] * inv; v[3] = o[dvh][4 * rq + 3] * inv;
            st4(orow + dvh * 32 + 8 * rq, v);
        }
}

template <int DK>
DI void attn_qk(const LAS unsigned char* kbuf, const int l32, const int hi, const bf16x8 (&qf)[DK / 16], f32x16& s0, f32x16& s1) {
    constexpr int KP = DK + 8;
#pragma unroll
    for (int r = 0; r < 16; ++r) { s0[r] = 0.f; s1[r] = 0.f; }
    const LAS unsigned char* kb = kbuf + (l32 * KP + 8 * hi) * 2;
#pragma unroll
    for (int c0 = 0; c0 < DK / 16; c0 += 2) {
        bf16x8 ka[2][2];
#pragma unroll
        for (int ds = 0; ds < 2; ++ds) { ka[0][ds] = *(const LAS bf16x8*)(kb + (c0 + ds) * 32); ka[1][ds] = *(const LAS bf16x8*)(kb + 32 * KP * 2 + (c0 + ds) * 32); }
#pragma unroll
        for (int ds = 0; ds < 2; ++ds) { s0 = MFMA32(ka[0][ds], qf[c0 + ds], s0); s1 = MFMA32(ka[1][ds], qf[c0 + ds], s1); }
    }
}
template <int DV, int MODE>
DI void attn_sm_pv(f32x16& s0, f32x16& s1, const LAS unsigned char* vbuf, const LAS float* cb, const int j, const int q0w, const int qrow, const int l32, const int hi,
                   f32x16 (&o)[DV / 32], float& mrun, float& lrun) {
    constexpr int VP = 68;
    const LAS unsigned char* vb = vbuf + (l32 * VP + 4 * hi) * 2;
    if (MODE == 0) {
#pragma unroll
        for (int rq = 0; rq < 4; ++rq) {
            const f32x4 c0 = *(const LAS f32x4*)(cb + 8 * rq + 4 * hi), c1 = *(const LAS f32x4*)(cb + 32 + 8 * rq + 4 * hi);
#pragma unroll
            for (int jj = 0; jj < 4; ++jj) { s0[4 * rq + jj] -= c0[jj]; s1[4 * rq + jj] -= c1[jj]; }
        }
        if (64 * j + 63 > q0w) {
#pragma unroll
            for (int r = 0; r < 16; ++r) { const int kv = 64 * j + crow(r, hi); if (kv > qrow) s0[r] = -__builtin_inff(); if (kv + 32 > qrow) s1[r] = -__builtin_inff(); }
        }
    }
    float mx = fmaxf(s0[0], s1[0]);
#pragma unroll
    for (int r = 1; r < 16; ++r) mx = fmaxf(mx, fmaxf(s0[r], s1[r]));
    mx = fmaxf(mx, __shfl_xor(mx, 32));
    const float mn = fmaxf(mrun, mx);
    const float alpha = __builtin_amdgcn_exp2f(mrun - mn);
    mrun = mn;
    float ls = 0.f;
#pragma unroll
    for (int r = 0; r < 16; ++r) { s0[r] = __builtin_amdgcn_exp2f(s0[r] - mn); s1[r] = __builtin_amdgcn_exp2f(s1[r] - mn); ls += s0[r] + s1[r]; }
    lrun = lrun * alpha + ls;
#pragma unroll
    for (int i = 0; i < DV / 32; ++i)
#pragma unroll
        for (int r = 0; r < 16; ++r) o[i][r] *= alpha;
    bf16x8 pf[4];
    pf[0] = pack8(s0[0], s0[1], s0[2], s0[3], s0[4], s0[5], s0[6], s0[7]);
    pf[1] = pack8(s0[8], s0[9], s0[10], s0[11], s0[12], s0[13], s0[14], s0[15]);
    pf[2] = pack8(s1[0], s1[1], s1[2], s1[3], s1[4], s1[5], s1[6], s1[7]);
    pf[3] = pack8(s1[8], s1[9], s1[10], s1[11], s1[12], s1[13], s1[14], s1[15]);
#pragma unroll
    for (int dvp = 0; dvp < DV / 32; dvp += 2) {
        u32x2 wlo[2][4], whi[2][4];
#pragma unroll
        for (int d2 = 0; d2 < 2; ++d2)
#pragma unroll
            for (int f = 0; f < 4; ++f) {
                const int off = (dvp + d2) * 32 * VP * 2 + (32 * (f >> 1) + 16 * (f & 1)) * 2;
                wlo[d2][f] = *(const LAS u32x2*)(vb + off); whi[d2][f] = *(const LAS u32x2*)(vb + off + 16);
            }
#pragma unroll
        for (int d2 = 0; d2 < 2; ++d2)
#pragma unroll
            for (int f = 0; f < 4; ++f) {
                u32x4 av; av.x = wlo[d2][f].x; av.y = wlo[d2][f].y; av.z = whi[d2][f].x; av.w = whi[d2][f].y;
                o[dvp + d2] = MFMA32(__builtin_bit_cast(bf16x8, av), pf[f], o[dvp + d2]);
            }
    }
}
template <int DK, int DV, int MODE, int K1C>
DI void attn_unit_p(LAS unsigned char* lds, const AttnP& a, const int q0, const int tid_in) {
    int tid = tid_in; asm volatile("" : "+v"(tid));
    constexpr int KP = DK + 8, VP = 68;
    constexpr int KBYTES = 64 * KP * 2, VBYTES = DV * VP * 2;
    constexpr int KCH = DK / 8, NKC = 64 * KCH, KPT = (NKC + 511) / 512;
    constexpr int VCH = DV / 8, NVT = 32 * VCH;
    LAS unsigned char* Kb = lds; LAS unsigned char* Vb = lds + 2 * KBYTES; LAS float* Cb = (LAS float*)(lds + 2 * KBYTES + 2 * VBYTES);
    const int wave = tid >> 6, lane = tid & 63, l32 = lane & 31, hi = lane >> 5;
    const int q0w = q0 + 32 * wave, qrow = q0w + l32;
    const int ntiles = (q0 + 256) / 64;
    const int wtiles = (MODE == 0) ? ((q0w + 31) / 64 + 1) : (q0w / 64 + 1);
    bf16x8 qf[DK / 16];
#pragma unroll
    for (int ds = 0; ds < DK / 16; ++ds) qf[ds] = *(const bf16x8*)(a.q + (size_t)qrow * a.qp + ds * 16 + 8 * hi);
    f32x16 o[DV / 32];
#pragma unroll
    for (int i = 0; i < DV / 32; ++i)
#pragma unroll
        for (int r = 0; r < 16; ++r) o[i][r] = 0.f;
    float mrun = -__builtin_inff(), lrun = 0.f;
    u32x4 krA[KPT], krB[KPT]; u32x4 vrA0 = {0, 0, 0, 0}, vrA1 = {0, 0, 0, 0}, vrB0 = {0, 0, 0, 0}, vrB1 = {0, 0, 0, 0}; float crA = 0.f, crB = 0.f;
    const int vkvp = tid / VCH, vdvg = tid % VCH;
#define ATP_GLOADK(S, J) do { if ((J) < ntiles) { \
        _Pragma("unroll") for (int p_ = 0; p_ < KPT; ++p_) { const int ci_ = tid + 512 * p_; if (ci_ < NKC) { const int row_ = ci_ / KCH, cc_ = ci_ % KCH; \
            const bf16_t* src_ = (cc_ < K1C) ? (a.k1 + (size_t)(64 * (J) + row_) * a.k1p + cc_ * 8) : (a.k2 + (size_t)(64 * (J) + row_) * a.k2p + (cc_ - K1C) * 8); \
            kr##S[p_] = *(const u32x4*)src_; } } } } while (0)
#define ATP_GLOADV(S, J) do { if ((J) < ntiles) { \
        if (tid < NVT) { const bf16_t* vs_ = a.v + (size_t)(64 * (J) + 2 * vkvp) * a.vp + vdvg * 8; vr##S##0 = *(const u32x4*)vs_; vr##S##1 = *(const u32x4*)(vs_ + a.vp); } \
        if (MODE == 0 && tid < 64) cr##S = a.bias[64 * (J) + tid]; } } while (0)
#define ATP_LWRITEK(S, B, J) do { if ((J) < ntiles) { \
        _Pragma("unroll") for (int p_ = 0; p_ < KPT; ++p_) { const int ci_ = tid + 512 * p_; if (ci_ < NKC) { const int row_ = ci_ / KCH, cc_ = ci_ % KCH; \
            *(LAS u32x4*)(Kb + (B) * KBYTES + (row_ * KP + cc_ * 8) * 2) = kr##S[p_]; } } } } while (0)
#define ATP_LWRITEV(S, B, J) do { if ((J) < ntiles) { \
        if (tid < NVT) { LAS unsigned char* vd_ = Vb + (B) * VBYTES + ((vdvg * 8) * VP + 2 * vkvp) * 2; \
            _Pragma("unroll") for (int w_ = 0; w_ < 4; ++w_) { \
                *(LAS unsigned*)(vd_ + (2 * w_) * VP * 2) = (vr##S##0[w_] & 0xffffu) | (vr##S##1[w_] << 16); \
                *(LAS unsigned*)(vd_ + (2 * w_ + 1) * VP * 2) = (vr##S##0[w_] >> 16) | (vr##S##1[w_] & 0xffff0000u); } } \
        if (MODE == 0 && tid < 64) Cb[(B) * 64 + tid] = cr##S; } } while (0)
    ATP_GLOADK(A, 0); ATP_GLOADV(A, 0); ATP_GLOADK(B, 1); ATP_GLOADV(B, 1);
    ATP_LWRITEK(A, 0, 0); ATP_LWRITEV(A, 0, 0);
    ATP_GLOADK(A, 2); ATP_GLOADV(A, 2);
    ATT_BAR();
    f32x16 sa0, sa1, sb0, sb1;
    attn_qk<DK>(Kb, l32, hi, qf, sa0, sa1);
    ATP_LWRITEK(B, 1, 1); ATP_GLOADK(B, 3);
    for (int j = 0; j < ntiles; j += 2) {
        ATT_BAR();
        if (j + 1 < wtiles) attn_qk<DK>(Kb + KBYTES, l32, hi, qf, sb0, sb1);
        if (j < wtiles) attn_sm_pv<DV, MODE>(sa0, sa1, Vb, Cb, j, q0w, qrow, l32, hi, o, mrun, lrun);
        ATP_LWRITEK(A, 0, j + 2); ATP_GLOADK(A, j + 4);
        ATP_LWRITEV(B, 1, j + 1); ATP_GLOADV(B, j + 3);
        ATT_BAR();
        if (j + 2 < wtiles) attn_qk<DK>(Kb, l32, hi, qf, sa0, sa1);
        if (j + 1 < wtiles) attn_sm_pv<DV, MODE>(sb0, sb1, Vb + VBYTES, Cb + 64, j + 1, q0w, qrow, l32, hi, o, mrun, lrun);
        ATP_LWRITEK(B, 1, j + 3); ATP_GLOADK(B, j + 5);
        ATP_LWRITEV(A, 0, j + 2); ATP_GLOADV(A, j + 4);
    }
    ATT_BAR();
#undef ATP_GLOADK
#undef ATP_GLOADV
#undef ATP_LWRITEK
#undef ATP_LWRITEV
    const float lt = lrun + __shfl_xor(lrun, 32);
    const float inv = 1.0f / lt;
    bf16_t* orow = a.o + (size_t)qrow * a.op + 4 * hi;
#pragma unroll
    for (int dvh = 0; dvh < DV / 32; ++dvh)
#pragma unroll
        for (int rq = 0; rq < 4; ++rq) {
            f32x4 v; v[0] = o[dvh][4 * rq] * inv; v[1] = o[dvh][4 * rq + 1] * inv; v[2] = o[dvh][4 * rq + 2] * inv; v[3] = o[dvh][4 * rq + 3] * inv;
            st4(orow + dvh * 32 + 8 * rq, v);
        }
}

constexpr int XA_KP = 136, XA_VP = 260, XA_KBYTES = 256 * XA_KP * 2, XA_VBYTES = 128 * XA_VP * 2;
DI void attn_xa_block(LAS unsigned char* lds, const bf16_t* kg, const bf16_t* vg, int kvp, const bf16_t* qg, int qp, bf16_t* og, int op, const int q0, const int nunits, const int tid_in) {
    int tid = tid_in; asm volatile("" : "+v"(tid));
    LAS unsigned char* Kb = lds; LAS unsigned char* Vb = lds + XA_KBYTES;
    const int wave = tid >> 6, lane = tid & 63, l32 = lane & 31, hi = lane >> 5;
#pragma unroll
    for (int p = 0; p < 8; ++p) { const int ci = tid + 512 * p, row = ci >> 4, cc = ci & 15;
        *(LAS u32x4*)(Kb + (row * XA_KP + cc * 8) * 2) = *(const u32x4*)(kg + (size_t)row * kvp + cc * 8); }
#pragma unroll
    for (int p = 0; p < 4; ++p) { const int ci = tid + 512 * p, kp2 = ci >> 4, dvg = ci & 15;
        const bf16_t* vs = vg + (size_t)(2 * kp2) * kvp + dvg * 8; const u32x4 v0 = *(const u32x4*)vs, v1 = *(const u32x4*)(vs + kvp);
        LAS unsigned char* vd = Vb + ((dvg * 8) * XA_VP + 2 * kp2) * 2;
#pragma unroll
        for (int w = 0; w < 4; ++w) { *(LAS unsigned*)(vd + (2 * w) * XA_VP * 2) = (v0[w] & 0xffffu) | (v1[w] << 16); *(LAS unsigned*)(vd + (2 * w + 1) * XA_VP * 2) = (v0[w] >> 16) | (v1[w] & 0xffff0000u); } }
    __syncthreads();
#pragma unroll 1
    for (int un = 0; un < nunits; ++un) {
        const int qrow = q0 + 256 * un + 32 * wave + l32;
        bf16x8 qf[8];
#pragma unroll
        for (int ds = 0; ds < 8; ++ds) qf[ds] = *(const bf16x8*)(qg + (size_t)qrow * qp + ds * 16 + 8 * hi);
        f32x16 o[4];
#pragma unroll
        for (int i = 0; i < 4; ++i)
#pragma unroll
            for (int r = 0; r < 16; ++r) o[i][r] = 0.f;
        float mrun = -__builtin_inff(), lrun = 0.f;
#pragma unroll 1
        for (int j = 0; j < 4; ++j) attn_tile<128, 128, 2, XA_VP>(Kb + j * 64 * XA_KP * 2, Vb + j * 64 * 2, nullptr, j, 0, qrow, l32, hi, 0.f, qf, o, mrun, lrun);
        const float lt = lrun + __shfl_xor(lrun, 32);
        const float inv = 1.0f / lt;
        bf16_t* orow = og + (size_t)qrow * op + 4 * hi;
#pragma unroll
        for (int dvh = 0; dvh < 4; ++dvh)
#pragma unroll
            for (int rq = 0; rq < 4; ++rq) {
                f32x4 v; v[0] = o[dvh][4 * rq] * inv; v[1] = o[dvh][4 * rq + 1] * inv; v[2] = o[dvh][4 * rq + 2] * inv; v[3] = o[dvh][4 * rq + 3] * inv;
                st4(orow + dvh * 32 + 8 * rq, v);
            }
    }
    __syncthreads();
}

template <int DK, int DV, int MODE, int K1C>
DI void attn_unit_s(LAS unsigned char* lds, const AttnP& a, const int q0, const int tid_in) {
    int tid = tid_in; asm volatile("" : "+v"(tid));
    constexpr int KP = DK + 8, VP = 260;
    constexpr int KBYTES = 256 * KP * 2, VBYTES = DV * VP * 2;
    constexpr int KCH = DK / 8, NKC = 256 * KCH, KPT = NKC / 512;
    constexpr int VCH = DV / 8, NVI = 128 * VCH, VPT = NVI / 512;
    LAS unsigned char* Kb = lds; LAS unsigned char* Vb = lds + KBYTES; LAS float* Cb = (LAS float*)(lds + KBYTES + VBYTES);
    const int wave = tid >> 6, lane = tid & 63, l32 = lane & 31, hi = lane >> 5;
    const int q0w = q0 + 32 * wave, qrow = q0w + l32;
    const int nsup = (q0 + 256) / 256;
    const int wtiles = (MODE == 0) ? ((q0w + 31) / 64 + 1) : (q0w / 64 + 1);
    bf16x8 qf[DK / 16];
#pragma unroll
    for (int ds = 0; ds < DK / 16; ++ds) qf[ds] = *(const bf16x8*)(a.q + (size_t)qrow * a.qp + ds * 16 + 8 * hi);
    f32x16 o[DV / 32];
#pragma unroll
    for (int i = 0; i < DV / 32; ++i)
#pragma unroll
        for (int r = 0; r < 16; ++r) o[i][r] = 0.f;
    float mrun = -__builtin_inff(), lrun = 0.f;
    u32x4 kr[KPT], vr[VPT][2]; float cr = 0.f;
#define ATS_GLOAD(S) do { \
        _Pragma("unroll") for (int p_ = 0; p_ < KPT; ++p_) { const int ci_ = tid + 512 * p_, row_ = ci_ / KCH, cc_ = ci_ % KCH; \
            const bf16_t* src_ = (cc_ < K1C) ? (a.k1 + (size_t)(256 * (S) + row_) * a.k1p + cc_ * 8) : (a.k2 + (size_t)(256 * (S) + row_) * a.k2p + (cc_ - K1C) * 8); \
            kr[p_] = *(const u32x4*)src_; } \
        _Pragma("unroll") for (int p_ = 0; p_ < VPT; ++p_) { const int ci_ = tid + 512 * p_, kp2_ = ci_ / VCH, dvg_ = ci_ % VCH; \
            const bf16_t* vs_ = a.v + (size_t)(256 * (S) + 2 * kp2_) * a.vp + dvg_ * 8; vr[p_][0] = *(const u32x4*)vs_; vr[p_][1] = *(const u32x4*)(vs_ + a.vp); } \
        if (MODE == 0 && tid < 256) cr = a.bias[256 * (S) + tid]; } while (0)
#define ATS_LWRITE() do { \
        _Pragma("unroll") for (int p_ = 0; p_ < KPT; ++p_) { const int ci_ = tid + 512 * p_, row_ = ci_ / KCH, cc_ = ci_ % KCH; \
            *(LAS u32x4*)(Kb + (row_ * KP + cc_ * 8) * 2) = kr[p_]; } \
        _Pragma("unroll") for (int p_ = 0; p_ < VPT; ++p_) { const int ci_ = tid + 512 * p_, kp2_ = ci_ / VCH, dvg_ = ci_ % VCH; \
            LAS unsigned char* vd_ = Vb + ((dvg_ * 8) * VP + 2 * kp2_) * 2; \
            _Pragma("unroll") for (int w_ = 0; w_ < 4; ++w_) { \
                *(LAS unsigned*)(vd_ + (2 * w_) * VP * 2) = (vr[p_][0][w_] & 0xffffu) | (vr[p_][1][w_] << 16); \
                *(LAS unsigned*)(vd_ + (2 * w_ + 1) * VP * 2) = (vr[p_][0][w_] >> 16) | (vr[p_][1][w_] & 0xffff0000u); } } \
        if (MODE == 0 && tid < 256) Cb[tid] = cr; } while (0)
    ATS_GLOAD(0);
#pragma unroll 1
    for (int S = 0; S < nsup; ++S) {
        ATT_BAR();
        ATS_LWRITE();
        if (S + 1 < nsup) ATS_GLOAD(S + 1);
        ATT_BAR();
#pragma unroll 1
        for (int t = 0; t < 4; ++t) {
            const int j = 4 * S + t;
            if (j < wtiles) attn_tile<DK, DV, MODE, VP>(Kb + t * 64 * KP * 2, Vb + t * 64 * 2, Cb + 64 * t, j, q0w, qrow, l32, hi, 0.f, qf, o, mrun, lrun);
        }
    }
    ATT_BAR();
#undef ATS_GLOAD
#undef ATS_LWRITE
    const float lt = lrun + __shfl_xor(lrun, 32);
    const float inv = 1.0f / lt;
    bf16_t* orow = a.o + (size_t)qrow * a.op + 4 * hi;
#pragma unroll
    for (int dvh = 0; dvh < DV / 32; ++dvh)
#pragma unroll
        for (int rq = 0; rq < 4; ++rq) {
            f32x4 v; v[0] = o[dvh][4 * rq] * inv; v[1] = o[dvh][4 * rq + 1] * inv; v[2] = o[dvh][4 * rq + 2] * inv; v[3] = o[dvh][4 * rq + 3] * inv;
            st4(orow + dvh * 32 + 8 * rq, v);
        }
}

template <int DK, int DV, int K1C>
DI void attn_unit_fd(LAS unsigned char* lds, const AttnP& a, const int q0, const int tid_in) {
    int tid = tid_in; asm volatile("" : "+v"(tid));
    constexpr int KP = DK + 8, VP = 260;
    constexpr int KBYTES = 256 * KP * 2, VBYTES = DV * VP * 2;
    constexpr int KCH = DK / 8, NKC = 256 * KCH, KPT = NKC / 512;
    constexpr int VCH = DV / 8, NVI = 128 * VCH, VPT = NVI / 512;
    LAS unsigned char* Kb = lds; LAS unsigned char* Vb = lds + KBYTES; LAS float* Cb = (LAS float*)(lds + KBYTES + VBYTES);
    volatile LAS unsigned* vote = (volatile LAS unsigned*)(Cb + 256);
    const int wave = tid >> 6, lane = tid & 63, l32 = lane & 31, hi = lane >> 5;
    const int q0w = q0 + 32 * wave, qrow = q0w + l32;
    const int nsup = (q0 + 256) / 256;
    const int wtiles = (q0w + 31) / 64 + 1;
    bf16x8 qf[DK / 16];
    float qn2 = 0.f;
#pragma unroll
    for (int ds = 0; ds < DK / 16; ++ds) {
        qf[ds] = *(const bf16x8*)(a.q + (size_t)qrow * a.qp + ds * 16 + 8 * hi);
#pragma unroll
        for (int e = 0; e < 8; ++e) { const float v = bf2f((unsigned short)qf[ds][e]); qn2 += v * v; }
    }
    qn2 += __shfl_xor(qn2, 32);
    const float bq = sqrtf(qn2) * a.kmax * 1.0009765625f + 1.0f;
    f32x16 o[DV / 32];
#pragma unroll
    for (int i = 0; i < DV / 32; ++i)
#pragma unroll
        for (int r = 0; r < 16; ++r) o[i][r] = 0.f;
    float mrun = -__builtin_inff(), lrun = 0.f;
    bool done = false;
    u32x4 kr[KPT], vr[VPT][2]; float cr = 0.f;
#define AFD_GLOAD(S) do { \
        _Pragma("unroll") for (int p_ = 0; p_ < KPT; ++p_) { const int ci_ = tid + 512 * p_, row_ = ci_ / KCH, cc_ = ci_ % KCH; \
            kr[p_] = *(const u32x4*)(a.k1 + (size_t)(256 * (S) + row_) * a.k1p + cc_ * 8); } \
        _Pragma("unroll") for (int p_ = 0; p_ < VPT; ++p_) { const int ci_ = tid + 512 * p_, kp2_ = ci_ / VCH, dvg_ = ci_ % VCH; \
            const bf16_t* vs_ = a.v + (size_t)(256 * (S) + 2 * kp2_) * a.vp + dvg_ * 8; vr[p_][0] = *(const u32x4*)vs_; vr[p_][1] = *(const u32x4*)(vs_ + a.vp); } \
        if (tid < 256) cr = a.bias[256 * (S) + tid]; } while (0)
#define AFD_LWRITE() do { \
        _Pragma("unroll") for (int p_ = 0; p_ < KPT; ++p_) { const int ci_ = tid + 512 * p_, row_ = ci_ / KCH, cc_ = ci_ % KCH; \
            *(LAS u32x4*)(Kb + (row_ * KP + cc_ * 8) * 2) = kr[p_]; } \
        _Pragma("unroll") for (int p_ = 0; p_ < VPT; ++p_) { const int ci_ = tid + 512 * p_, kp2_ = ci_ / VCH, dvg_ = ci_ % VCH; \
            LAS unsigned char* vd_ = Vb + ((dvg_ * 8) * VP + 2 * kp2_) * 2; \
            _Pragma("unroll") for (int w_ = 0; w_ < 4; ++w_) { \
                *(LAS unsigned*)(vd_ + (2 * w_) * VP * 2) = (vr[p_][0][w_] & 0xffffu) | (vr[p_][1][w_] << 16); \
                *(LAS unsigned*)(vd_ + (2 * w_ + 1) * VP * 2) = (vr[p_][0][w_] >> 16) | (vr[p_][1][w_] & 0xffff0000u); } } \
        if (tid < 256) Cb[tid] = cr; } while (0)
    AFD_GLOAD(nsup - 1);
#pragma unroll 1
    for (int S = nsup - 1; S >= 0; --S) {
        ATT_BAR();
        if (S != nsup - 1 && vote[S & 1] == 0u) break;
        AFD_LWRITE();
        if (S > 0) AFD_GLOAD(S - 1);
        if (tid == 0) vote[(S + 1) & 1] = 0u;
        ATT_BAR();
#pragma unroll 1
        for (int t = 3; t >= 0; --t) {
            const int j = 4 * S + t;
            if (j < wtiles && !done) {
                const float ub = bq - Cb[64 * t + 63] - mrun;
                if (__all(ub < -64.0f)) done = true;
                else attn_tile<DK, DV, 0, VP>(Kb + t * 64 * KP * 2, Vb + t * 64 * 2, Cb + 64 * t, j, q0w, qrow, l32, hi, 0.f, qf, o, mrun, lrun);
            }
        }
        if (!done && S > 0 && lane == 0) vote[(S - 1) & 1] = 1u;
    }
    ATT_BAR();
#undef AFD_GLOAD
#undef AFD_LWRITE
    const float lt = lrun + __shfl_xor(lrun, 32);
    const float inv = 1.0f / lt;
    bf16_t* orow = a.o + (size_t)qrow * a.op + 4 * hi;
#pragma unroll
    for (int dvh = 0; dvh < DV / 32; ++dvh)
#pragma unroll
        for (int rq = 0; rq < 4; ++rq) {
            f32x4 v; v[0] = o[dvh][4 * rq] * inv; v[1] = o[dvh][4 * rq + 1] * inv; v[2] = o[dvh][4 * rq + 2] * inv; v[3] = o[dvh][4 * rq + 3] * inv;
            st4(orow + dvh * 32 + 8 * rq, v);
        }
}
DI void fox_kmax_item(int item, const bf16_t* z, unsigned* kmax2bits, int tid) {
    const int bh = item >> 3, seg = item & 7, b = bh >> 2, h = bh & 3;
    const bf16_t* kp = z + (size_t)(b * SEQ + seg * 512 + tid) * ZP + ZC_FK + h * 64; float ss = 0.f;
#pragma unroll
    for (int c = 0; c < 8; ++c) { const u32x4 w = *(const u32x4*)(kp + 8 * c);
        ss += (bflo(w.x) * bflo(w.x) + bfhi(w.x) * bfhi(w.x)) + (bflo(w.y) * bflo(w.y) + bfhi(w.y) * bfhi(w.y)) + (bflo(w.z) * bflo(w.z) + bfhi(w.z) * bfhi(w.z)) + (bflo(w.w) * bflo(w.w) + bfhi(w.w) * bfhi(w.w)); }
#pragma unroll
    for (int o = 1; o < 64; o <<= 1) ss = fmaxf(ss, __shfl_xor(ss, o));
    if ((tid & 63) == 0) atomicMax(kmax2bits + bh, __float_as_uint(ss));
}

DI float wave_sum(float v) {
#pragma unroll
    for (int o = 1; o < 64; o <<= 1) v += __shfl_xor(v, o);
    return v;
}
DI void norm_row(const float* xr, const float* g, bf16_t* ob, float* of, int lane) {
    f32x4 v[4]; float ss = 0.f;
#pragma unroll
    for (int j = 0; j < 4; ++j) { v[j] = *(const f32x4*)(xr + 4 * lane + 256 * j); ss += (v[j][0] * v[j][0] + v[j][1] * v[j][1]) + (v[j][2] * v[j][2] + v[j][3] * v[j][3]); }
    const float rstd = rsqrtf(wave_sum(ss) * (1.f / 1024.f) + EPS);
#pragma unroll
    for (int j = 0; j < 4; ++j) {
        const f32x4 gg = *(const f32x4*)(g + 4 * lane + 256 * j);
        const f32x4 y = v[j] * rstd * gg;
        if (ob) st4(ob + 4 * lane + 256 * j, y); else *(f32x4*)(of + 4 * lane + 256 * j) = y;
    }
}
DI void rawnorm_phase(const float* x, bf16_t* ob, float* ssout, int nrows, int tid) {
    const int gw = blockIdx.x * 8 + (tid >> 6), ngw = gridDim.x * 8, lane = tid & 63;
    int r = gw;
    for (; r + 7 * ngw < nrows; r += 8 * ngw) {
        f32x4 v[8][4];
#pragma unroll
        for (int q = 0; q < 8; ++q)
#pragma unroll
            for (int j = 0; j < 4; ++j) v[q][j] = *(const f32x4*)(x + (size_t)(r + q * ngw) * 1024 + 4 * lane + 256 * j);
#pragma unroll
        for (int q = 0; q < 8; ++q) {
            float ss = 0.f;
#pragma unroll
            for (int j = 0; j < 4; ++j) { const f32x4 w = v[q][j]; ss += (w[0] * w[0] + w[1] * w[1]) + (w[2] * w[2] + w[3] * w[3]); st4(ob + (size_t)(r + q * ngw) * 1024 + 4 * lane + 256 * j, w); }
            ss = wave_sum(ss);
            if (lane < 16) ssout[(size_t)(r + q * ngw) * 16 + lane] = (lane == 0) ? ss : 0.f;
        }
    }
    for (; r < nrows; r += ngw) {
        const float* xr = x + (size_t)r * 1024; float ss = 0.f;
#pragma unroll
        for (int j = 0; j < 4; ++j) { const f32x4 v = *(const f32x4*)(xr + 4 * lane + 256 * j); ss += (v[0] * v[0] + v[1] * v[1]) + (v[2] * v[2] + v[3] * v[3]); st4(ob + (size_t)r * 1024 + 4 * lane + 256 * j, v); }
        ss = wave_sum(ss);
        if (lane < 16) ssout[(size_t)r * 16 + lane] = (lane == 0) ? ss : 0.f;
    }
}
DI void norm_phase(const float* x, const float* g, bf16_t* ob, float* of, int nrows, int tid) {
    const int gw = blockIdx.x * 8 + (tid >> 6), ngw = gridDim.x * 8, lane = tid & 63;
    for (int r = gw; r < nrows; r += ngw) norm_row(x + (size_t)r * 1024, g, ob ? ob + (size_t)r * 1024 : nullptr, of ? of + (size_t)r * 1024 : nullptr, lane);
}

DI int map_win(int n) {
    if (n < 768) return n;
    if (n < 1792) return n + 4;
    if (n < 2720) return n + 20;
    if (n < 2724) return 768 + (n - 2720);
    if (n < 2736) return -1;
    if (n < 2752) return 1796 + (n - 2736);
    return -1;
}
DI void transpose_job(const float* src, int Ns, int K, int Nd, int mapmode, int off, bf16_t* dst, LAS float* tile, int tid, int rot, const float* ks = nullptr) {
    const int nkt = K / 64, ntiles = (Nd / 256) * nkt;
    const int G = gridDim.x;
    for (int t = (blockIdx.x + rot) % G; t < ntiles; t += G) {
        const int n0 = (t / nkt) * 256, k0 = (t % nkt) * 64;
        int sc[4];
#pragma unroll
        for (int q = 0; q < 4; ++q) { const int nn = n0 + 64 * q + (tid & 63); sc[q] = mapmode ? map_win(nn) : off + nn; }
#pragma unroll
        for (int p = 0; p < 8; ++p) {
            const int kk = (tid >> 6) + 8 * p;
            const float sk = ks ? ks[k0 + kk] : 1.f;
            const float* sr = src + (size_t)(k0 + kk) * Ns;
#pragma unroll
            for (int q = 0; q < 4; ++q) tile[kk * 257 + 64 * q + (tid & 63)] = (sc[q] >= 0) ? sr[sc[q]] * sk : 0.f;
        }
        __syncthreads();
        const int kc = tid & 7;
#pragma unroll
        for (int q = 0; q < 4; ++q) {
            const int nl = (tid >> 3) + 64 * q;
            const LAS float* s = tile + (kc * 8) * 257 + nl;
            u32x4 w; w.x = pk2(s[0], s[257]); w.y = pk2(s[2 * 257], s[3 * 257]); w.z = pk2(s[4 * 257], s[5 * 257]); w.w = pk2(s[6 * 257], s[7 * 257]);
            *(u32x4*)(dst + (size_t)(n0 + nl) * K + k0 + kc * 8) = w;
        }
        __syncthreads();
    }
}

constexpr size_t WS_CTL = 0;
constexpr size_t WL_WIN = 0, WL_WG = WL_WIN + (size_t)2816 * 1024 * 2, WL_UPF = WL_WG + (size_t)3072 * 1024 * 2, WL_UPG = WL_UPF + (size_t)1024 * 256 * 2,
                 WL_UPM = WL_UPG + (size_t)1024 * 512 * 2, WL_OUT = WL_UPM + (size_t)1024 * 256 * 2, WL_XQ = WL_OUT + (size_t)1024 * 1024 * 2, WL_XKV = WL_XQ + (size_t)512 * 1024 * 2,
                 WL_XO = WL_XKV + (size_t)1024 * 1024 * 2, WL_W1 = WL_XO + (size_t)1024 * 512 * 2, WL_W2 = WL_W1 + (size_t)4096 * 1024 * 2, WL_WM = WL_W2 + (size_t)4096 * 1024 * 2,
                 WL_SIZE = WL_WM + (size_t)1024 * 384 * 2;
constexpr size_t WS_W = 65536;
constexpr size_t WS_LF = WS_W + 2 * WL_SIZE;
constexpr size_t WS_CUM = WS_LF + (size_t)T_TOK * 4 * 4;
constexpr size_t WS_SSQ = WS_CUM + (size_t)T_TOK * 4 * 4;
constexpr size_t WS_GA = WS_SSQ + (size_t)2 * T_TOK * 8 * 4;
constexpr size_t WS_MEMN = WS_GA + (size_t)2048 * 64 * 4;
constexpr size_t WS_KVX = WS_MEMN + (size_t)2 * 2048 * 1024 * 2;
constexpr size_t WS_UT = WS_KVX + (size_t)2 * 2048 * 1024 * 2;
constexpr size_t WS_R0 = WS_UT + (size_t)2048 * 128 * 64 * 2;
constexpr size_t R_Z = WS_R0, R_O = R_Z + (size_t)T_TOK * ZP * 2, R_QH = R_O + (size_t)T_TOK * 1024 * 2, R_KVB = R_QH + (size_t)T_TOK * 384 * 2, R_H = R_KVB + (size_t)T_TOK * 512 * 2,
                 R_END = R_H + (size_t)T_TOK * 1024 * 2;
constexpr size_t R_GTMP = R_Z, R_Y = R_Z + (size_t)T_TOK * 1024 * 2;
constexpr size_t R_QX = R_Z, R_OX = R_Z + (size_t)T_TOK * 512 * 2;
constexpr size_t R_HID = R_Z;
static_assert(R_HID + (size_t)T_TOK * 4096 * 2 <= R_H, "workspace aliasing");
constexpr size_t WS_SSX = R_END;
constexpr size_t WS_NEED = WS_SSX + (size_t)7 * T_TOK * 16 * 4;

struct Params {
    const void* p[28];
};

constexpr int LDS_BYTES = 139264 + 64;
DI const float* inp(const Params& P, int i) { asm volatile("" : "+s"(i)); return (const float*)P.p[i]; }
DI float* outp(const Params& P) { int i = 26; asm volatile("" : "+s"(i)); return (float*)P.p[i]; }
DI unsigned char* wsp(const Params& P) { int i = 27; asm volatile("" : "+s"(i)); return (unsigned char*)P.p[i]; }

DI void gla_a_unit(int unit, const bf16_t* z, const float* wg, const float* bgate, bf16_t* uT, float* ga, int lane) {
    const int b = unit >> 8, h = (unit >> 6) & 3, c = unit & 63;
    const int l32 = lane & 31, hi = lane >> 5;
    const bf16_t* zb = z + (size_t)(b * SEQ + c * 64) * ZP;
    bf16x8 gfr[2];
#pragma unroll
    for (int tt = 0; tt < 2; ++tt) gfr[tt] = *(const bf16x8*)(zb + (size_t)(l32 + 32 * tt) * ZP + ZC_GLOW + 8 * hi);
    unsigned short kraw[2][2][16];
#pragma unroll
    for (int dt = 0; dt < 2; ++dt)
#pragma unroll
        for (int tt = 0; tt < 2; ++tt)
#pragma unroll
            for (int r = 0; r < 16; ++r) kraw[dt][tt][r] = zb[(size_t)(crow(r, hi) + 32 * tt) * ZP + ZC_GK + h * 64 + l32 + 32 * dt];
    bf16x8 vt[2][2];
#define GA_VLOAD(ET) do { const bf16_t* vb_ = zb + ZC_GV + h * 128 + 32 * (ET) + l32 + (size_t)(4 * hi) * ZP; \
        _Pragma("unroll") for (int tt = 0; tt < 2; ++tt) _Pragma("unroll") for (int s = 0; s < 2; ++s) { bf16x8 f_; \
            _Pragma("unroll") for (int j = 0; j < 8; ++j) { const int t_ = (j & 3) + 8 * (2 * s + (j >> 2)) + 32 * tt; f_[j] = (short)vb_[(size_t)t_ * ZP]; } \
            vt[tt][s] = f_; } } while (0)
    GA_VLOAD(0);
    __builtin_amdgcn_sched_barrier(0);
    bf16x8 kd[2][2][2];
#pragma unroll
    for (int dt = 0; dt < 2; ++dt) {
        const int d = l32 + 32 * dt, col = h * 64 + d;
        float wv[8];
#pragma unroll
        for (int j = 0; j < 8; ++j) wv[j] = wg[(8 * hi + j) * 256 + col];
        const bf16x8 wb = pack8(wv[0], wv[1], wv[2], wv[3], wv[4], wv[5], wv[6], wv[7]);
        const float bg = bgate[col];
        f32x16 pre[2];
#pragma unroll
        for (int tt = 0; tt < 2; ++tt) {
            f32x16 zz;
#pragma unroll
            for (int r = 0; r < 16; ++r) zz[r] = 0.f;
            pre[tt] = MFMA32(gfr[tt], wb, zz);
        }
        float tot[8];
#pragma unroll
        for (int tt = 0; tt < 2; ++tt)
#pragma unroll
            for (int q = 0; q < 4; ++q) {
                float run = 0.f;
#pragma unroll
                for (int jj = 0; jj < 4; ++jj) { run += logsig(pre[tt][4 * q + jj] + bg) * (1.f / 16.f); pre[tt][4 * q + jj] = run; }
                tot[4 * tt + q] = run;
            }
        float run = 0.f;
#pragma unroll
        for (int m = 0; m < 8; ++m) {
            const float pm = __shfl_xor(tot[m], 32);
            const float off = run + (hi ? pm : 0.f);
            run += tot[m] + pm;
#pragma unroll
            for (int jj = 0; jj < 4; ++jj) pre[m >> 2][4 * (m & 3) + jj] += off;
        }
        const float end = run;
#pragma unroll
        for (int tt = 0; tt < 2; ++tt)
#pragma unroll
            for (int s = 0; s < 2; ++s) {
                float x[8];
#pragma unroll
                for (int j = 0; j < 8; ++j) { const int r = 8 * s + j; x[j] = bf2f(kraw[dt][tt][r]) * __builtin_amdgcn_exp2f((end - pre[tt][r]) * LOG2E); }
                kd[dt][tt][s] = pack8(x[0], x[1], x[2], x[3], x[4], x[5], x[6], x[7]);
            }
        if (hi == 0) ga[(size_t)unit * 64 + d] = __builtin_amdgcn_exp2f(end * LOG2E);
    }
#pragma unroll
    for (int et = 0; et < 4; ++et) {
        bf16x8 vc[2][2];
#pragma unroll
        for (int tt = 0; tt < 2; ++tt)
#pragma unroll
            for (int s = 0; s < 2; ++s) vc[tt][s] = vt[tt][s];
        if (et + 1 < 4) GA_VLOAD(et + 1);
        __builtin_amdgcn_sched_barrier(0);
#pragma unroll
        for (int dt = 0; dt < 2; ++dt) {
            f32x16 acc;
#pragma unroll
            for (int r = 0; r < 16; ++r) acc[r] = 0.f;
#pragma unroll
            for (int tt = 0; tt < 2; ++tt)
#pragma unroll
                for (int s = 0; s < 2; ++s) acc = MFMA32(kd[dt][tt][s], vc[tt][s], acc);
            bf16_t* up = uT + ((size_t)unit * 128 + 32 * et + l32) * 64 + 32 * dt + 4 * hi;
#pragma unroll
            for (int q4 = 0; q4 < 4; ++q4) { f32x4 v; v[0] = acc[4 * q4]; v[1] = acc[4 * q4 + 1]; v[2] = acc[4 * q4 + 2]; v[3] = acc[4 * q4 + 3]; st4(up + 8 * q4, v); }
        }
        __builtin_amdgcn_sched_barrier(0);
    }
#undef GA_VLOAD
}
DI void gla_b_phase(bf16_t* uT, const float* ga, int tid) {
    for (int gid = blockIdx.x * 512 + tid; gid < 32 * 4096; gid += gridDim.x * 512) {
        const int bh = gid >> 12, idx = gid & 4095, elem = idx * 2, d = elem & 63;
        unsigned* up = (unsigned*)(uT + (size_t)bh * 64 * 8192 + elem);
        const float* ap = ga + (size_t)bh * 64 * 64 + d;
        float s0 = 0.f, s1 = 0.f;
        unsigned u[16]; f32x2 av[16];
#pragma unroll 1
        for (int c0 = 0; c0 < 64; c0 += 16) {
#pragma unroll
            for (int i = 0; i < 16; ++i) { u[i] = up[(size_t)(c0 + i) * 4096]; av[i] = *(const f32x2*)(ap + (c0 + i) * 64); }
#pragma unroll
            for (int i = 0; i < 16; ++i) { s0 = av[i][0] * s0 + bflo(u[i]); s1 = av[i][1] * s1 + bfhi(u[i]); up[(size_t)(c0 + i) * 4096] = pk2(s0, s1); }
        }
    }
}
DI void gla_c_unit(int w, const bf16_t* z, const bf16_t* uT, const float* gout, bf16_t* obuf, int lane) {
    const int bhc = w >> 1, th = w & 1;
    const int b = bhc >> 8, h = (bhc >> 6) & 3, c = bhc & 63;
    const int l32 = lane & 31, hi = lane >> 5;
    const int row = b * SEQ + c * 64 + 32 * th + l32;
    const bf16_t* zr = z + (size_t)row * ZP;
    bf16x8 qb[4];
#pragma unroll
    for (int s = 0; s < 4; ++s) qb[s] = *(const bf16x8*)(zr + ZC_GQ + h * 64 + 16 * s + 8 * hi);
    f32x16 acc[4]; float ss = 0.f;
#pragma unroll
    for (int et = 0; et < 4; ++et) {
#pragma unroll
        for (int r = 0; r < 16; ++r) acc[et][r] = 0.f;
        const bf16_t* sp = uT + ((size_t)bhc * 128 + 32 * et + l32) * 64 + 8 * hi;
#pragma unroll
        for (int s = 0; s < 4; ++s) acc[et] = MFMA32(*(const bf16x8*)(sp + 16 * s), qb[s], acc[et]);
#pragma unroll
        for (int r = 0; r < 16; ++r) ss += acc[et][r] * acc[et][r];
    }
    ss += __shfl_xor(ss, 32);
    const float sc = 0.125f * rsqrtf(ss * (1.f / 8192.f) + EPS);
#pragma unroll
    for (int et = 0; et < 4; ++et)
#pragma unroll
        for (int q4 = 0; q4 < 4; ++q4) {
            const int e0 = 8 * q4 + 4 * hi + 32 * et;
            const f32x4 g = *(const f32x4*)(gout + e0);
            const u32x2 rr = *(const u32x2*)(zr + ZC_GR + h * 128 + e0);
            f32x4 v;
            v[0] = acc[et][4 * q4] * sc * g[0] * bflo(rr.x); v[1] = acc[et][4 * q4 + 1] * sc * g[1] * bfhi(rr.x);
            v[2] = acc[et][4 * q4 + 2] * sc * g[2] * bflo(rr.y); v[3] = acc[et][4 * q4 + 3] * sc * g[3] * bfhi(rr.y);
            st4(obuf + (size_t)row * 1024 + 256 + h * 128 + e0, v);
        }
}
DI void fox_cumsum_block(int bh, const float* lf, float* cum, LAS float* red, int tid) {
    const int b = bh >> 2, h = bh & 3, lane = tid & 63, wave = tid >> 6;
    const float* src = lf + ((size_t)(b * SEQ + tid * 8)) * 4 + h;
    float v[8];
#pragma unroll
    for (int i = 0; i < 8; ++i) v[i] = src[i * 4];
#pragma unroll
    for (int i = 1; i < 8; ++i) v[i] += v[i - 1];
    const float tot = v[7];
    float x = tot;
#pragma unroll
    for (int o = 1; o < 64; o <<= 1) { const float y = __shfl_up(x, o); if (lane >= o) x += y; }
    if (lane == 63) red[wave] = x;
    __syncthreads();
    float base = x - tot;
#pragma unroll
    for (int w = 0; w < 8; ++w) if (w < wave) base += red[w];
    float* dst = cum + (size_t)bh * SEQ + tid * 8;
    f32x4 o0, o1;
#pragma unroll
    for (int i = 0; i < 4; ++i) { o0[i] = v[i] + base; o1[i] = v[4 + i] + base; }
    *(f32x4*)dst = o0; *(f32x4*)(dst + 4) = o1;
    __syncthreads();
}
#define XB_TMO      128
#define XB_XCNT(j)  (256  + 64 * (j))
#define XB_XSUB(j)  (1280 + 64 * (j))
#define XB_XGEN(j)  (2304 + 64 * (j))
#define XB_TOP      3328
#define XB_TOPGEN   3392
#define XCD_BAR_WORDS 3456
#define XB_SPIN_CAP (1u << 18)

__device__ __forceinline__ unsigned xb_ld(unsigned* p)              { return __hip_atomic_load(p, __ATOMIC_RELAXED, __HIP_MEMORY_SCOPE_AGENT); }
__device__ __forceinline__ unsigned xb_add(unsigned* p, unsigned v) { return __hip_atomic_fetch_add(p, v, __ATOMIC_RELAXED, __HIP_MEMORY_SCOPE_AGENT); }
__device__ __forceinline__ unsigned xb_xcc_id() { return (unsigned)__builtin_amdgcn_s_getreg((3 << 11) | 20) & 0xFu; }
#define XB_SPIN(cond, bar) do { unsigned _sp = 0; while (cond) { __builtin_amdgcn_s_sleep(1); \
    if ((++_sp & 255u) == 0u) { if (xb_ld(&(bar)[XB_TMO])) break; if (_sp > XB_SPIN_CAP) { atomicAdd(&(bar)[XB_TMO], 1u); break; } } } } while (0)

struct XcdBarrier {
    unsigned* bar; unsigned x;
    volatile LAS unsigned* st;
};

__device__ __forceinline__ XcdBarrier xcd_barrier_post(unsigned* bar, volatile LAS unsigned* st) {
    XcdBarrier b; b.bar = bar; b.x = xb_xcc_id(); b.st = st;
    if (threadIdx.x == 0) (void)xb_add(&bar[XB_XCNT(b.x)], 1u);
    return b;
}
__device__ __forceinline__ void xcd_barrier_complete(unsigned* bar, unsigned x, unsigned& nloc, unsigned& nx) {
    const unsigned G = gridDim.x * gridDim.y * gridDim.z;
    unsigned sum, cnt, mine, sp = 0u;
    for (;;) {
        sum = 0u; cnt = 0u; mine = 0u;
#pragma unroll
        for (unsigned j = 0; j < 16; ++j) { const unsigned c = xb_ld(&bar[XB_XCNT(j)]); sum += c; cnt += (c > 0u) ? 1u : 0u; mine = (j == x) ? c : mine; }
        if (sum == G) break;
        __builtin_amdgcn_s_sleep(1);
        if ((++sp & 255u) == 0u) { if (xb_ld(&bar[XB_TMO])) break; if (sp > XB_SPIN_CAP) { atomicAdd(&bar[XB_TMO], 1u); break; } }
    }
    nloc = mine > 0u ? mine : 1u; nx = cnt > 0u ? cnt : 1u;
}

__device__ __forceinline__ void xcd_barrier(const XcdBarrier& b) {
    asm volatile("s_waitcnt vmcnt(0)" ::: "memory");
    __syncthreads();
    if (threadIdx.x == 0) {
        unsigned* bar = b.bar;
        __builtin_amdgcn_s_waitcnt(0);
        unsigned nloc = b.st[0], nx = b.st[1];
        if (nloc == 0u) { xcd_barrier_complete(bar, b.x, nloc, nx); b.st[0] = nloc; b.st[1] = nx; }
        const unsigned old = xb_add(&bar[XB_XSUB(b.x)], 1u);
        const unsigned gen = old / nloc;
        if (old + 1u == (gen + 1u) * nloc) {
            __builtin_amdgcn_fence(__ATOMIC_RELEASE, "agent");
            asm volatile("s_waitcnt vmcnt(0)" ::: "memory");
            const unsigned og = xb_add(&bar[XB_TOP], 1u);
            const unsigned tg = og / nx;
            if (og + 1u == (tg + 1u) * nx) xb_add(&bar[XB_TOPGEN], 1u);
            else XB_SPIN(xb_ld(&bar[XB_TOPGEN]) == tg, bar);
            __builtin_amdgcn_fence(__ATOMIC_ACQUIRE, "agent");
            xb_add(&bar[XB_XGEN(b.x)], 1u);
            asm volatile("s_waitcnt vmcnt(0)" ::: "memory");
        } else {
            XB_SPIN(xb_ld(&bar[XB_XGEN(b.x)]) == gen, bar);
            __builtin_amdgcn_fence(__ATOMIC_ACQUIRE, "agent");
            asm volatile("s_waitcnt vmcnt(0)" ::: "memory");
        }
    }
    __syncthreads();

}
DI int ltid() { int t = threadIdx.x; asm volatile("" : "+v"(t)); return t; }
#define PHASE_PRE const int tid = ltid(); const int lane = tid & 63, wave = tid >> 6; const int G = gridDim.x; (void)lane; (void)wave; (void)G;
#define WSPTRS PHASE_PRE \
    unsigned char* ws = wsp(P); float* xres = outp(P); (void)xres; \
    float* lf = (float*)(ws + WS_LF); float* cum = (float*)(ws + WS_CUM); float* ga = (float*)(ws + WS_GA); bf16_t* uT = (bf16_t*)(ws + WS_UT); \
    bf16_t* zb = (bf16_t*)(ws + R_Z); bf16_t* hb = (bf16_t*)(ws + R_H); bf16_t* ob = (bf16_t*)(ws + R_O); bf16_t* qh = (bf16_t*)(ws + R_QH); bf16_t* kvb = (bf16_t*)(ws + R_KVB); \
    bf16_t* gtmp = (bf16_t*)(ws + R_GTMP); bf16_t* yb = (bf16_t*)(ws + R_Y); bf16_t* qx = (bf16_t*)(ws + R_QX); bf16_t* ox = (bf16_t*)(ws + R_OX); \
    bf16_t* hid = (bf16_t*)(ws + R_HID); \
    float* ssx = (float*)(ws + WS_SSX); (void)ssx; \
    const unsigned char* wl = ws + WS_W + (size_t)l * WL_SIZE; float* ssq = (float*)(ws + WS_SSQ) + (size_t)l * T_TOK * 8; bf16_t* kvx = (bf16_t*)(ws + WS_KVX) + (size_t)l * 2048 * 1024; \
    (void)lf; (void)cum; (void)ga; (void)uT; (void)zb; (void)hb; (void)ob; (void)qh; (void)kvb; (void)gtmp; (void)yb; (void)qx; (void)ox; (void)hid; (void)wl; (void)ssq; (void)kvx;
template <int l>
DI void layer_body(const Params& P, LAS unsigned char* lds, const XcdBarrier& bar) {
        { WSPTRS
            EpiA e{}; e.mode = 1; e.z = zb; e.lf = lf; e.ssq = ssq; e.bfox = inp(P, 4) + l * 4; e.rs_in = ssx + (size_t)(l == 0 ? 6 : 2) * T_TOK * 16;
            run_gemm(lds, hb, 1024, (const bf16_t*)(wl + WL_WIN), T_TOK, 2816, 1024, e, 0);
            EpiB e2{}; e2.mode = 0; e2.out = kvx; e2.ldc = 1024; e2.scale = 1.f;
            run_gemm(lds, (const bf16_t*)(ws + WS_MEMN) + (size_t)l * 2048 * 1024, 1024, (const bf16_t*)(wl + WL_XKV), 2048, 1024, 1024, e2, 128);
        }
        xcd_barrier(bar);
        { WSPTRS
            EpiA e{}; e.mode = 2; e.ssq = ssq; e.qh = qh; e.kvb = kvb;
            run_gemm(lds, zb + ZC_MQ, ZP, (const bf16_t*)(wl + WL_WM), T_TOK, 1024, 384, e, 0);
            const float* wg = inp(P, 5) + (size_t)l * 16 * 256; const float* bgate = inp(P, 6) + l * 256;
            for (int u = blockIdx.x * 8 + wave; u < 2048; u += G * 8) gla_a_unit(u, zb, wg, bgate, uT, ga, lane);
            for (int bh = (blockIdx.x + 128) % G; bh < 32; bh += G) fox_cumsum_block(bh, lf, cum, (LAS float*)lds, tid);
            for (int it = blockIdx.x; it < 256; it += G) fox_kmax_item(it, zb, (unsigned*)(ws + WS_CTL + 32768) + l * 32, tid);
        }
        xcd_barrier(bar);
        { WSPTRS
            gla_b_phase(uT, ga, tid);
            for (int vb = blockIdx.x; vb < 256; vb += G) {
                const int xcd = vb & 7, idx = vb >> 3;
                const int bh = xcd * 4 + (idx >> 3), sidx = idx & 7;
                const int b = bh >> 2, h = bh & 3;
                AttnP af; af.q = zb + (size_t)(b * SEQ) * ZP + ZC_FQ + h * 64; af.qp = ZP;
                af.k1 = zb + (size_t)(b * SEQ) * ZP + ZC_FK + h * 64; af.k1p = ZP; af.k2 = af.k1; af.k2p = ZP;
                af.v = zb + (size_t)(b * SEQ) * ZP + ZC_FV + h * 64; af.vp = ZP;
                af.o = ob + (size_t)(b * SEQ) * 1024 + h * 64; af.op = 1024; af.bias = cum + (size_t)bh * SEQ; af.kmax = sqrtf(((const float*)(ws + WS_CTL + 32768))[l * 32 + bh]);
                AttnP am; am.q = qh + (size_t)(b * SEQ) * 384 + h * 96; am.qp = 384;
                am.k1 = kvb + (size_t)(b * SEQ) * 512 + h * 128; am.k1p = 512; am.k2 = zb + (size_t)(b * SEQ) * ZP + ZC_MKR; am.k2p = ZP;
                am.v = kvb + (size_t)(b * SEQ) * 512 + h * 128 + 64; am.vp = 512;
                am.o = ob + (size_t)(b * SEQ) * 1024 + 768 + h * 64; am.op = 1024; am.bias = nullptr; am.kmax = 0.f;
                attn_unit_fd<64, 64, 8>(lds, af, (15 - sidx) * 256, tid);
                attn_unit_s<96, 64, 1, 8>(lds, am, (15 - sidx) * 256, tid);
                attn_unit_fd<64, 64, 8>(lds, af, sidx * 256, tid);
                attn_unit_s<96, 64, 1, 8>(lds, am, sidx * 256, tid);
            }
        }
        xcd_barrier(bar);
        { WSPTRS
            const float* gout = inp(P, 7) + l * 128;
            for (int w = blockIdx.x * 8 + wave; w < 4096; w += G * 8) gla_c_unit(w, zb, uT, gout, ob, lane);
        }
        xcd_barrier(bar);
        { WSPTRS
            const float* bgb = inp(P, 12) + (size_t)l * 3072;
            for (int br = 0; br < 3; ++br) {
                EpiB eg{}; eg.mode = 2; eg.out = gtmp; eg.ldc = 1024; eg.bias = bgb + br * 1024; eg.rs_in = ssx + (size_t)(l == 0 ? 6 : 2) * T_TOK * 16;
                run_gemm(lds, hb, 1024, (const bf16_t*)(wl + WL_WG) + (size_t)br * 1024 * 1024, T_TOK, 1024, 1024, eg, 0);
                EpiB eu{}; eu.mode = 3; eu.out = yb; eu.ldc = 1024; eu.gate = gtmp; eu.first = (br == 0);
                const bf16_t* Ab = ob + (br == 0 ? 0 : (br == 1 ? 256 : 768));
                const bf16_t* Wb = (const bf16_t*)(wl + (br == 0 ? WL_UPF : (br == 1 ? WL_UPG : WL_UPM)));
                run_gemm(lds, Ab, 1024, Wb, T_TOK, 1024, (br == 1) ? 512 : 256, eu, 0);
            }
        }
        xcd_barrier(bar);
        { WSPTRS
            EpiA e{}; e.mode = 0; e.xin_b = hb; e.xout_b = hb; e.ss_out = ssx + (size_t)(l * 3) * T_TOK * 16;
            run_gemm(lds, yb, 1024, (const bf16_t*)(wl + WL_OUT), T_TOK, 1024, 1024, e, 0);
        }
        xcd_barrier(bar);
        { WSPTRS
            EpiB e{}; e.mode = 0; e.out = qx; e.ldc = 512; e.scale = QS_XA; e.rs_in = ssx + (size_t)(l * 3) * T_TOK * 16;
            run_gemm(lds, hb, 1024, (const bf16_t*)(wl + WL_XQ), T_TOK, 512, 1024, e, 0);
        }
        xcd_barrier(bar);
        { WSPTRS
            for (int up = blockIdx.x; up < 256; up += G) {
                const int b = up >> 5, h = (up >> 3) & 3, qp2 = up & 7;
                attn_xa_block(lds, kvx + (size_t)(b * MEMLEN) * 1024 + h * 128, kvx + (size_t)(b * MEMLEN) * 1024 + 512 + h * 128, 1024,
                              qx + (size_t)(b * SEQ) * 512 + h * 128, 512, ox + (size_t)(b * SEQ) * 512 + h * 128, 512, qp2 * 512, 2, tid);
            }
        }
        xcd_barrier(bar);
        { WSPTRS
            EpiA e{}; e.mode = 0; e.xin_b = hb; e.xout_b = hb; e.ss_out = ssx + (size_t)(l * 3 + 1) * T_TOK * 16;
            run_gemm(lds, ox, 512, (const bf16_t*)(wl + WL_XO), T_TOK, 1024, 512, e, 0);
        }
        xcd_barrier(bar);
        { WSPTRS
            EpiB e{}; e.mode = 1; e.out = hid; e.ldc = 4096; e.rs_in = ssx + (size_t)(l * 3 + 1) * T_TOK * 16;
            run_gemm(lds, hb, 1024, (const bf16_t*)(wl + WL_W1), T_TOK, 4096, 1024, e, 0);
        }
        xcd_barrier(bar);
        { WSPTRS
            EpiA e{}; e.mode = 0; e.xin_b = hb; e.xout_b = hb; e.ss_out = ssx + (size_t)(l * 3 + 2) * T_TOK * 16;
            run_gemm(lds, hid, 4096, (const bf16_t*)(wl + WL_W2), T_TOK, 1024, 4096, e, 0);
        }
        xcd_barrier(bar);
        if (l == 0) {
        } else { WSPTRS
            const float* gf = inp(P, 25); const float* ssf = ssx + (size_t)5 * T_TOK * 16;
            const int ngw = G * 8;
            f32x4 gg[4];
#pragma unroll
            for (int jq = 0; jq < 4; ++jq) gg[jq] = *(const f32x4*)(gf + 4 * lane + 256 * jq);
            int r = blockIdx.x * 8 + wave;
            for (; r + 3 * ngw < T_TOK; r += 4 * ngw) {
                float rstd[4]; u32x2 xv[4][4];
#pragma unroll
                for (int q = 0; q < 4; ++q) {
                    rstd[q] = rowstat16(ssf + (size_t)(r + q * ngw) * 16);
#pragma unroll
                    for (int jq = 0; jq < 4; ++jq) xv[q][jq] = *(const u32x2*)(hb + (size_t)(r + q * ngw) * 1024 + 4 * lane + 256 * jq);
                }
#pragma unroll
                for (int q = 0; q < 4; ++q) {
                    const float rs = rsqrtf(rstd[q] * (1.f / 1024.f) + EPS);
#pragma unroll
                    for (int jq = 0; jq < 4; ++jq) {
                        f32x4 y; y[0] = bflo(xv[q][jq].x) * rs * gg[jq][0]; y[1] = bfhi(xv[q][jq].x) * rs * gg[jq][1]; y[2] = bflo(xv[q][jq].y) * rs * gg[jq][2]; y[3] = bfhi(xv[q][jq].y) * rs * gg[jq][3];
                        *(f32x4*)(xres + (size_t)(r + q * ngw) * 1024 + 4 * lane + 256 * jq) = y;
                    }
                }
            }
            for (; r < T_TOK; r += ngw) {
                const float rs = rsqrtf(rowstat16(ssf + (size_t)r * 16) * (1.f / 1024.f) + EPS);
#pragma unroll
                for (int jq = 0; jq < 4; ++jq) {
                    const u32x2 xw = *(const u32x2*)(hb + (size_t)r * 1024 + 4 * lane + 256 * jq);
                    f32x4 y; y[0] = bflo(xw.x) * rs * gg[jq][0]; y[1] = bfhi(xw.x) * rs * gg[jq][1]; y[2] = bflo(xw.y) * rs * gg[jq][2]; y[3] = bfhi(xw.y) * rs * gg[jq][3];
                    *(f32x4*)(xres + (size_t)r * 1024 + 4 * lane + 256 * jq) = y;
                }
            }
        }
}

__global__ void __launch_bounds__(512, 2) fwd_megakernel(Params P) {
    extern __shared__ __attribute__((aligned(16))) unsigned char lds_raw[];
    LAS unsigned char* lds = (LAS unsigned char*)lds_raw;
    cg::grid_group grid = cg::this_grid();
    volatile LAS unsigned* bst = (volatile LAS unsigned*)(lds + 139264);
    if (threadIdx.x == 0) { bst[0] = 0u; bst[1] = 0u; }
    __syncthreads();
    const XcdBarrier bar = xcd_barrier_post((unsigned*)(wsp(P) + WS_CTL), bst);
    {
        PHASE_PRE
        unsigned char* ws = wsp(P); bf16_t* hb = (bf16_t*)(ws + R_H); const float* x_in = inp(P, 0); const float* mem = inp(P, 1);
        float* ssx = (float*)(ws + WS_SSX);
        LAS float* tile = (LAS float*)lds;
        for (int l = 0; l < 2; ++l) {
            unsigned char* wl = ws + WS_W + (size_t)l * WL_SIZE;
            const float* w_in = inp(P, 3) + (size_t)l * 1024 * 5812;
            transpose_job(w_in, 5812, 1024, 2816, 1, 0, (bf16_t*)(wl + WL_WIN), tile, tid, (0 + 144 * l) & 255, inp(P, 2) + l * 1024);
            transpose_job(w_in, 5812, 1024, 3072, 0, 2740, (bf16_t*)(wl + WL_WG), tile, tid, (80 + 144 * l) & 255, inp(P, 2) + l * 1024);
            transpose_job(inp(P, 13) + (size_t)l * 256 * 1024, 1024, 256, 1024, 0, 0, (bf16_t*)(wl + WL_UPF), tile, tid, (144 + 144 * l) & 255);
            transpose_job(inp(P, 14) + (size_t)l * 512 * 1024, 1024, 512, 1024, 0, 0, (bf16_t*)(wl + WL_UPG), tile, tid, (128 + 144 * l) & 255);
            transpose_job(inp(P, 15) + (size_t)l * 256 * 1024, 1024, 256, 1024, 0, 0, (bf16_t*)(wl + WL_UPM), tile, tid, (96 + 144 * l) & 255);
            transpose_job(inp(P, 16) + (size_t)l * 1024 * 1024, 1024, 1024, 1024, 0, 0, (bf16_t*)(wl + WL_OUT), tile, tid, (80 + 144 * l) & 255);
            transpose_job(inp(P, 19) + (size_t)l * 1024 * 512, 512, 1024, 512, 0, 0, (bf16_t*)(wl + WL_XQ), tile, tid, (16 + 144 * l) & 255, inp(P, 17) + l * 1024);
            transpose_job(inp(P, 20) + (size_t)l * 1024 * 1024, 1024, 1024, 1024, 0, 0, (bf16_t*)(wl + WL_XKV), tile, tid, (240 + 144 * l) & 255);
            transpose_job(inp(P, 21) + (size_t)l * 512 * 1024, 1024, 512, 1024, 0, 0, (bf16_t*)(wl + WL_XO), tile, tid, (176 + 144 * l) & 255);
            transpose_job(inp(P, 23) + (size_t)l * 1024 * 4096, 4096, 1024, 4096, 0, 0, (bf16_t*)(wl + WL_W1), tile, tid, (144 + 144 * l) & 255, inp(P, 22) + l * 1024);
            transpose_job(inp(P, 24) + (size_t)l * 4096 * 1024, 1024, 4096, 1024, 0, 0, (bf16_t*)(wl + WL_W2), tile, tid, (144 + 144 * l) & 255);
            bf16_t* wm = (bf16_t*)(wl + WL_WM);
            const float* gq = inp(P, 8) + l * 256; const float* wuq = inp(P, 9) + (size_t)l * 256 * 384;
            const float* gkv = inp(P, 10) + l * 128; const float* wukv = inp(P, 11) + (size_t)l * 128 * 512;
            for (int i = blockIdx.x * 512 + tid; i < 1024 * 384; i += G * 512) {
                const int n = i / 384, k = i - n * 384; float v = 0.f;
                if (n < 384) { if (k < 256) v = gq[k] * wuq[(size_t)k * 384 + n]; }
                else if (n < 896) { if (k >= 256) v = gkv[k - 256] * wukv[(size_t)(k - 256) * 512 + (n - 384)]; }
                wm[i] = (bf16_t)(pk2(v, 0.f) & 0xffffu);
            }
            norm_phase(mem, inp(P, 18) + l * 1024, (bf16_t*)(ws + WS_MEMN) + (size_t)l * 2048 * 1024, nullptr, 2048, tid);
        }
        rawnorm_phase(x_in, hb, ssx + (size_t)6 * T_TOK * 16, T_TOK, tid);
    }
    grid.sync();

    layer_body<0>(P, lds, bar);
    layer_body<1>(P, lds, bar);
}

extern "C" void kernel_launch(void* const* d_in, const int* in_sizes, int n_in, void* d_out, int out_size, void* d_ws, size_t ws_size, hipStream_t stream) {
    static int grid_blocks = 0;
    if (grid_blocks == 0) {
        if (n_in != 26 || ws_size < WS_NEED) { fprintf(stderr, "kernel_launch: expected 26 inputs and >= %zu bytes of workspace (got %d, %zu)\n", (size_t)WS_NEED, n_in, ws_size); grid_blocks = -1; return; }
        int dev = 0, cus = 0, per_cu = 0;
        (void)hipGetDevice(&dev);
        (void)hipDeviceGetAttribute(&cus, hipDeviceAttributeMultiprocessorCount, dev);
        if (hipFuncSetAttribute((const void*)fwd_megakernel, hipFuncAttributeMaxDynamicSharedMemorySize, LDS_BYTES) != hipSuccess) { fprintf(stderr, "kernel_launch: hipFuncSetAttribute failed\n"); grid_blocks = -1; return; }
        if (hipOccupancyMaxActiveBlocksPerMultiprocessor(&per_cu, (const void*)fwd_megakernel, 512, LDS_BYTES) != hipSuccess || per_cu < 1) { fprintf(stderr, "kernel_launch: occupancy query gave %d\n", per_cu); per_cu = 1; }
        (void)hipGetLastError();
        grid_blocks = cus;
    }
    if (grid_blocks < 0) return;
    if (hipMemsetAsync(d_ws, 0, 65536, stream) != hipSuccess) { fprintf(stderr, "kernel_launch: hipMemsetAsync failed\n"); return; }
    Params p{};
    for (int i = 0; i < 26; ++i) p.p[i] = d_in[i];
    p.p[26] = d_out; p.p[27] = d_ws;
    void* args[] = {&p};
    hipError_t e = hipLaunchCooperativeKernel((const void*)fwd_megakernel, dim3(grid_blocks), dim3(512), args, LDS_BYTES, stream);
    if (e != hipSuccess) fprintf(stderr, "cooperative launch failed: %s (grid %d)\n", hipGetErrorString(e), grid_blocks);
}
```

```cpp
#include <hip/hip_runtime.h>
#include <hip/hip_cooperative_groups.h>
#include <cstdio>
#include <cstdint>
namespace cg = cooperative_groups;

#define LAS __attribute__((address_space(3)))
typedef unsigned short bf16_t;
typedef short bf16x8 __attribute__((ext_vector_type(8)));
typedef float f32x4 __attribute__((ext_vector_type(4)));
typedef float f32x2 __attribute__((ext_vector_type(2)));
typedef float f32x16 __attribute__((ext_vector_type(16)));
typedef unsigned u32x4 __attribute__((ext_vector_type(4)));
typedef unsigned u32x2 __attribute__((ext_vector_type(2)));
typedef __bf16 bf16x2n __attribute__((ext_vector_type(2)));

#define DI __device__ __forceinline__
DI unsigned pk2(float lo, float hi) { f32x2 f = {lo, hi}; bf16x2n b = __builtin_convertvector(f, bf16x2n); return __builtin_bit_cast(unsigned, b); }
DI float bf2f(unsigned short b) { return __uint_as_float(((unsigned)b) << 16); }
DI float bflo(unsigned w) { return __uint_as_float(w << 16); }
DI float bfhi(unsigned w) { return __uint_as_float(w & 0xffff0000u); }
DI void st4(bf16_t* p, f32x4 v) { u32x2 w; w.x = pk2(v[0], v[1]); w.y = pk2(v[2], v[3]); *(u32x2*)p = w; }
DI bf16x8 pack8(float a0, float a1, float a2, float a3, float a4, float a5, float a6, float a7) {
    u32x4 w; w.x = pk2(a0, a1); w.y = pk2(a2, a3); w.z = pk2(a4, a5); w.w = pk2(a6, a7); return __builtin_bit_cast(bf16x8, w);
}
#define MFMA32(a, b, c) __builtin_amdgcn_mfma_f32_32x32x16_bf16((a), (b), (c), 0, 0, 0)
DI int crow(int r, int hi) { return (r & 3) + 8 * (r >> 2) + 4 * hi; }

constexpr int T_TOK = 32768, SEQ = 4096, NBATCH = 8, DM = 1024, MEMLEN = 256;
constexpr int ZP = 2816;
constexpr int ZC_FQ = 0, ZC_FK = 256, ZC_FV = 512, ZC_GQ = 768, ZC_GK = 1024, ZC_GV = 1280, ZC_GR = 1792, ZC_MQ = 2304, ZC_MKV = 2560, ZC_MKR = 2688, ZC_FF = 2720, ZC_GLOW = 2736;
constexpr float LOG2E = 1.4426950408889634f;
constexpr float QS_FOX = 0.125f * LOG2E;
constexpr float QS_MLA = 0.10206207261596575f * LOG2E;
constexpr float QS_XA = 0.08838834764831845f * LOG2E;
constexpr float EPS = 1e-6f;

DI float logsig(float x) { return fminf(x, 0.f) - __logf(1.f + __expf(-fabsf(x))); }
DI float sigmoidf_(float x) { return __builtin_amdgcn_rcpf(1.f + __expf(-x)); }
DI float siluf_(float x) { return x * __builtin_amdgcn_rcpf(1.f + __expf(-x)); }
DI void rope_cs(int pos, int i, float& c, float& s) {
    const float inv = exp2f((float)i * (-13.287712379549449f / 16.0f));
    const float ang = (float)pos * inv;
    double rev = (double)ang * 0.15915494309189535;
    rev -= __builtin_rint(rev);
    const float rf = (float)rev;
    s = __builtin_amdgcn_sinf(rf); c = __builtin_amdgcn_cosf(rf);
}

namespace pg8 {
#define PG8_LAS __attribute__((address_space(3)))
constexpr int BM = 256, BK = 64, HALF = 128, HTB = HALF * BK * 2  , STAGE_BYTES = 8 * HTB, NXCD = 8, WGM = 8;
__host__ __device__ __forceinline__ int lds_byte(int r, int c) { const int st = (r >> 4) * 2 + (c >> 5), rr = r & 15, cc = c & 31, ob = rr * 64 + cc * 2; return st * 1024 + (ob ^ (((ob >> 9) & 1) << 5)); }
__host__ __device__ __forceinline__ void stage_rc(int b, int& R, int& C) { const int st = b / 1024, sb = b % 1024, swz = sb ^ (((sb >> 9) & 1) << 5); R = (st >> 1) * 16 + swz / 64; C = (st & 1) * 32 + (swz % 64) / 2; }
__host__ __device__ __forceinline__ int perm32(int rho) { const int n = rho >> 4, i = rho & 15; return 8 * (i >> 2) + 4 * n + (i & 3); }
struct Unit { int pm, pn; };
struct Gemm { const bf16_t* A; const bf16_t* Bt; int M, N, K, lda; };
struct StaticOrder {
    int nM, nN, nwg, G, c;
    __host__ __device__ void init(int M, int N, int G_, int c_) { nM = M / BM; nN = N / BM; nwg = nM * nN; G = G_; c = c_; }
    __host__ __device__ bool next(int i, Unit& u) const {
        const long L = (long)i * G + c; if (L >= nwg) return false;
        int wgid = (int)L; { const int q = nwg / NXCD, r = nwg % NXCD, xcd = wgid % NXCD, off = wgid / NXCD; wgid = (xcd < r ? xcd * (q + 1) : r * (q + 1) + (xcd - r) * q) + off; }
        const int nig = WGM * nN, gid = wgid / nig, fm = gid * WGM, gsz = (nM - fm) < WGM ? (nM - fm) : WGM;
        u.pm = fm + ((wgid % nig) % gsz); u.pn = (wgid % nig) / gsz; return true;
    }
    __device__ __forceinline__ void a_ready(const Unit&) const {}
    __device__ __forceinline__ void done(const Unit&) const {}
};
template <class Epi, class Sched, bool ALIGN_EPI = false, bool SP2 = false>
__device__ __forceinline__ void gemm_phase(PG8_LAS unsigned char* lds, const Gemm g, const Sched& S, const Epi& E) {
    int tid = threadIdx.x; asm volatile("" : "+v"(tid)); const int wid = __builtin_amdgcn_readfirstlane(tid >> 6), lane = tid & 63, wr = wid >> 2, wc = wid & 3, fr = lane & 15, fq = lane >> 4;
    const int K = g.K, nt = K / BK;
    unsigned voffA[2], voffB[2];
#pragma unroll
    for (int i = 0; i < 2; ++i) { int R, C; stage_rc(tid * 16 + i * 8192, R, C); const int Rb = Epi::PERM ? ((R & ~31) + perm32(R & 31)) : R;
        voffA[i] = (unsigned)(R * g.lda + C) * 2u; voffB[i] = (unsigned)(Rb * K + C) * 2u; }
    const size_t kstep = (size_t)(BK * 2);
    const size_t hstepA = (size_t)HALF * g.lda * 2, hstepB = (size_t)HALF * K * 2;
    const size_t tstepA = 2 * hstepA, tstepB = 2 * hstepB;
    const unsigned ldsw = (unsigned)wid * 1024u;
    const int aoff = lds_byte(wr * 64 + fr, fq * 8), boff = lds_byte(wc * 32 + fr, fq * 8);
#define PG8_SA(b, h) (((b) * 2 + (h)) * HTB)
#define PG8_SB(b, h) ((4 + (b) * 2 + (h)) * HTB)
#define PG8_STAGE(bufoff, gbase, voff) do { _Pragma("unroll") for (int _i = 0; _i < 2; ++_i) \
        __builtin_amdgcn_global_load_lds((const unsigned*)((const char*)(gbase) + (voff)[_i]), (PG8_LAS unsigned*)(lds + (bufoff) + ldsw + _i * 8192), 16, 0, 0); } while (0)
#define PG8_LDA(dst, b, h) do { _Pragma("unroll") for (int m = 0; m < 4; ++m) _Pragma("unroll") for (int k = 0; k < 2; ++k) dst[m][k] = *(const PG8_LAS bf16x8*)(lds + PG8_SA(b, h) + aoff + m * 2048 + k * 1024); } while (0)
#define PG8_LDB(dst, b, h) do { _Pragma("unroll") for (int n = 0; n < 2; ++n) _Pragma("unroll") for (int k = 0; k < 2; ++k) dst[n][k] = *(const PG8_LAS bf16x8*)(lds + PG8_SB(b, h) + boff + n * 2048 + k * 1024); } while (0)
#define PG8_MMA(ai, bj, At, Bt) do { __builtin_amdgcn_s_setprio(1); _Pragma("unroll") for (int m = 0; m < 4; ++m) _Pragma("unroll") for (int n = 0; n < 2; ++n) _Pragma("unroll") for (int k = 0; k < 2; ++k) \
        acc[ai][bj][m][n] = __builtin_amdgcn_mfma_f32_16x16x32_bf16(Bt[n][k], At[m][k], acc[ai][bj][m][n], 0, 0, 0); __builtin_amdgcn_s_setprio(0); } while (0)
#define PG8_WAIT_V(n) asm volatile("s_waitcnt vmcnt(" #n ")" ::: "memory")
#define PG8_WAIT_L(n) asm volatile("s_waitcnt lgkmcnt(" #n ")" ::: "memory")
#define PG8_BAR __builtin_amdgcn_s_barrier()
#define PG8_SCHED __builtin_amdgcn_sched_barrier(0)
    Unit cur, nxt; int ui = 0;
    if (!S.next(0, cur)) return;
    f32x4 acc[2][2][4][2];
#pragma unroll
    for (int a = 0; a < 2; ++a)
#pragma unroll
        for (int b = 0; b < 2; ++b)
#pragma unroll
            for (int m = 0; m < 4; ++m)
#pragma unroll
                for (int n = 0; n < 2; ++n) acc[a][b][m][n] = (f32x4){0.f, 0.f, 0.f, 0.f};
    bf16x8 At[4][2], B0[2][2], B1[2][2];
    const char* cA = (const char*)g.A + (size_t)cur.pm * tstepA; const char* cB = (const char*)g.Bt + (size_t)cur.pn * tstepB;
    S.a_ready(cur);
    if constexpr (SP2) {
        PG8_STAGE(PG8_SB(0, 0), cB, voffB); PG8_STAGE(PG8_SB(0, 1), cB + hstepB, voffB); PG8_STAGE(PG8_SA(0, 0), cA, voffA); PG8_STAGE(PG8_SA(0, 1), cA + hstepA, voffA);
        if (wr == 1) PG8_BAR;
        PG8_WAIT_V(2); PG8_BAR;
        PG8_STAGE(PG8_SB(1, 0), cB + kstep, voffB); PG8_STAGE(PG8_SA(1, 0), cA + kstep, voffA); PG8_STAGE(PG8_SB(1, 1), cB + hstepB + kstep, voffB);
        PG8_WAIT_V(6); PG8_BAR;
    } else {
        PG8_STAGE(PG8_SB(0, 0), cB, voffB); PG8_STAGE(PG8_SA(0, 0), cA, voffA); PG8_STAGE(PG8_SB(0, 1), cB + hstepB, voffB); PG8_STAGE(PG8_SA(0, 1), cA + hstepA, voffA);
        if (wr == 1) PG8_BAR;
        PG8_WAIT_V(4); PG8_BAR;
        PG8_STAGE(PG8_SB(1, 0), cB + kstep, voffB); PG8_STAGE(PG8_SA(1, 0), cA + kstep, voffA); PG8_STAGE(PG8_SB(1, 1), cB + hstepB + kstep, voffB);
        PG8_WAIT_V(6); PG8_BAR;
    }
    for (;;) {
        const bool has_next = S.next(ui + 1, nxt);
        const char* nA = has_next ? (const char*)g.A + (size_t)nxt.pm * tstepA : cA; const char* nB = has_next ? (const char*)g.Bt + (size_t)nxt.pn * tstepB : cB;
        for (int t = 0; t < nt; t += 2) {
            const bool last = (t == nt - 2);
            const char* a1 = cA + (size_t)(t + 1) * kstep;
            const char* a2 = last ? nA : cA + (size_t)(t + 2) * kstep; const char* b2 = last ? nB : cB + (size_t)(t + 2) * kstep;
            const char* a3 = a2 + kstep; const char* b3 = b2 + kstep;
            if (last && has_next) S.a_ready(nxt);
            if constexpr (SP2) {
            PG8_LDB(B0, 0, 0); PG8_LDB(B1, 0, 1); PG8_SCHED; PG8_LDA(At, 0, 0); PG8_STAGE(PG8_SA(1, 1), a1 + hstepA, voffA);
            PG8_WAIT_V(8); PG8_WAIT_L(0); PG8_BAR; PG8_MMA(0, 0, At, B0); PG8_MMA(0, 1, At, B1); PG8_BAR; PG8_SCHED;
            PG8_LDA(At, 0, 1); PG8_STAGE(PG8_SB(0, 0), b2, voffB); PG8_STAGE(PG8_SB(0, 1), b2 + hstepB, voffB); PG8_STAGE(PG8_SA(0, 0), a2, voffA);
            PG8_WAIT_V(8); PG8_WAIT_L(0); PG8_BAR; PG8_MMA(1, 0, At, B0); PG8_MMA(1, 1, At, B1); PG8_BAR; PG8_SCHED;
            PG8_LDB(B0, 1, 0); PG8_LDB(B1, 1, 1); PG8_SCHED; PG8_LDA(At, 1, 0); PG8_STAGE(PG8_SA(0, 1), a2 + hstepA, voffA);
            PG8_WAIT_V(8); PG8_WAIT_L(0); PG8_BAR; PG8_MMA(0, 0, At, B0); PG8_MMA(0, 1, At, B1); PG8_BAR; PG8_SCHED;
            PG8_LDA(At, 1, 1); PG8_STAGE(PG8_SB(1, 0), b3, voffB); PG8_STAGE(PG8_SB(1, 1), b3 + hstepB, voffB); PG8_STAGE(PG8_SA(1, 0), a3, voffA);
            PG8_WAIT_V(8); PG8_WAIT_L(0); PG8_BAR; PG8_MMA(1, 0, At, B0); PG8_MMA(1, 1, At, B1); PG8_BAR; PG8_SCHED;
            } else {
            PG8_LDB(B0, 0, 0); PG8_SCHED; PG8_LDA(At, 0, 0); PG8_STAGE(PG8_SA(1, 1), a1 + hstepA, voffA);
            PG8_WAIT_L(8); PG8_BAR; PG8_WAIT_L(0); PG8_MMA(0, 0, At, B0); PG8_BAR; PG8_SCHED;
            PG8_LDB(B1, 0, 1); PG8_STAGE(PG8_SB(0, 0), b2, voffB);
            PG8_BAR; PG8_WAIT_L(0); PG8_MMA(0, 1, At, B1); PG8_BAR;
            PG8_LDA(At, 0, 1); PG8_STAGE(PG8_SA(0, 0), a2, voffA);
            PG8_BAR; PG8_WAIT_L(0); PG8_MMA(1, 0, At, B0); PG8_BAR; PG8_SCHED;
            PG8_STAGE(PG8_SB(0, 1), b2 + hstepB, voffB);
            PG8_WAIT_V(6); PG8_BAR; PG8_MMA(1, 1, At, B1); PG8_BAR;
            PG8_LDB(B0, 1, 0); PG8_SCHED; PG8_LDA(At, 1, 0); PG8_STAGE(PG8_SA(0, 1), a2 + hstepA, voffA);
            PG8_WAIT_L(8); PG8_BAR; PG8_WAIT_L(0); PG8_MMA(0, 0, At, B0); PG8_BAR; PG8_SCHED;
            PG8_LDB(B1, 1, 1); PG8_STAGE(PG8_SB(1, 0), b3, voffB);
            PG8_BAR; PG8_WAIT_L(0); PG8_MMA(0, 1, At, B1); PG8_BAR;
            PG8_LDA(At, 1, 1); PG8_STAGE(PG8_SA(1, 0), a3, voffA);
            PG8_BAR; PG8_WAIT_L(0); PG8_MMA(1, 0, At, B0); PG8_BAR; PG8_SCHED;
            PG8_STAGE(PG8_SB(1, 1), b3 + hstepB, voffB);
            PG8_WAIT_V(6); PG8_BAR; PG8_MMA(1, 1, At, B1); PG8_BAR;
            }
        }
        if constexpr (ALIGN_EPI) { if (wr == 0) PG8_BAR; }
        if constexpr (!Epi::AFTER_DRAIN) { E(acc, cur, wr, wc, fr, fq); S.done(cur); }
        if (!has_next) break;
#pragma unroll
        for (int a = 0; a < 2; ++a)
#pragma unroll
            for (int b = 0; b < 2; ++b)
#pragma unroll
                for (int m = 0; m < 4; ++m)
#pragma unroll
                    for (int n = 0; n < 2; ++n) acc[a][b][m][n] = (f32x4){0.f, 0.f, 0.f, 0.f};
        cur = nxt; cA = nA; cB = nB; ++ui;
        if constexpr (ALIGN_EPI) { if (wr == 1) PG8_BAR; }
    }
    PG8_WAIT_V(0);
    if constexpr (!ALIGN_EPI) { if (wr == 0) PG8_BAR; }
    PG8_BAR;
    if constexpr (Epi::AFTER_DRAIN) { E.fused(acc, cur, wr, wc, fr, fq, lds, wid, lane); S.done(cur); }
#undef PG8_SA
#undef PG8_SB
#undef PG8_STAGE
#undef PG8_LDA
#undef PG8_LDB
#undef PG8_MMA
#undef PG8_WAIT_V
#undef PG8_WAIT_L
#undef PG8_BAR
#undef PG8_SCHED
}
}

DI float rowstat16(const float* p) {
    const f32x4 a = *(const f32x4*)p, b = *(const f32x4*)(p + 4), c = *(const f32x4*)(p + 8), d = *(const f32x4*)(p + 12);
    return (((a[0] + a[1]) + (a[2] + a[3])) + ((b[0] + b[1]) + (b[2] + b[3]))) + (((c[0] + c[1]) + (c[2] + c[3])) + ((d[0] + d[1]) + (d[2] + d[3])));
}
#define EPI_FENCE() do { asm volatile("" ::: "memory"); __builtin_amdgcn_sched_barrier(0); } while (0)
DI void rope8(f32x4& v0, f32x4& v1, const int pos, const int fq) {
    float own[8] = {v0[0], v0[1], v0[2], v0[3], v1[0], v1[1], v1[2], v1[3]}, oth[8];
#pragma unroll
    for (int t = 0; t < 8; ++t) oth[t] = __shfl_xor(own[t], 32);
    const bool first = fq < 2; const int ib = 8 * (fq & 1);
#pragma unroll
    for (int t = 0; t < 8; ++t) { float c, s; rope_cs(pos, ib + t, c, s); own[t] = first ? (own[t] * c - oth[t] * s) : (own[t] * c + oth[t] * s); }
    v0 = (f32x4){own[0], own[1], own[2], own[3]}; v1 = (f32x4){own[4], own[5], own[6], own[7]};
}
DI void st8(bf16_t* p, const f32x4& v0, const f32x4& v1) { u32x4 w; w.x = pk2(v0[0], v0[1]); w.y = pk2(v0[2], v0[3]); w.z = pk2(v1[0], v1[1]); w.w = pk2(v1[2], v1[3]); *(u32x4*)p = w; }
struct EpiA {
    static constexpr bool PERM = true, AFTER_DRAIN = false;
    int mode;
    const bf16_t* xin_b; bf16_t* xout_b; float* ss_out;
    const float* rs_in;
    bf16_t* z; float* lf; float* ssq; const float* bfox;
    bf16_t* qh; bf16_t* kvb;
    __device__ __forceinline__ void operator()(const f32x4 (&acc)[2][2][4][2], const pg8::Unit& u, int wr, int wc, int fr, int fq) const {
        const int rbase = u.pm * 256 + wr * 64 + fr;
        const int colb = u.pn * 256 + wc * 32 + 8 * fq;
        if (mode == 0) {
#pragma unroll
            for (int ai = 0; ai < 2; ++ai) {
                u32x4 xo[4][2];
#pragma unroll
                for (int m = 0; m < 4; ++m)
#pragma unroll
                    for (int bj = 0; bj < 2; ++bj) xo[m][bj] = *(const u32x4*)(xin_b + (size_t)(rbase + ai * 128 + m * 16) * 1024 + colb + bj * 128);
                EPI_FENCE();
#pragma unroll
                for (int m = 0; m < 4; ++m) {
                    const int row = rbase + ai * 128 + m * 16;
                    float ss = 0.f;
#pragma unroll
                    for (int bj = 0; bj < 2; ++bj) {
                        const u32x4 x = xo[m][bj];
                        f32x4 v0 = acc[ai][bj][m][0], v1 = acc[ai][bj][m][1];
                        v0[0] += bflo(x.x); v0[1] += bfhi(x.x); v0[2] += bflo(x.y); v0[3] += bfhi(x.y); v1[0] += bflo(x.z); v1[1] += bfhi(x.z); v1[2] += bflo(x.w); v1[3] += bfhi(x.w);
                        u32x4 w; w.x = pk2(v0[0], v0[1]); w.y = pk2(v0[2], v0[3]); w.z = pk2(v1[0], v1[1]); w.w = pk2(v1[2], v1[3]);
                        *(u32x4*)(xout_b + (size_t)row * 1024 + colb + bj * 128) = w;
                        const float r0 = bflo(w.x), r1 = bfhi(w.x), r2 = bflo(w.y), r3 = bfhi(w.y), r4 = bflo(w.z), r5 = bfhi(w.z), r6 = bflo(w.w), r7 = bfhi(w.w);
                        ss += ((r0 * r0 + r1 * r1) + (r2 * r2 + r3 * r3)) + ((r4 * r4 + r5 * r5) + (r6 * r6 + r7 * r7));
                    }
                    ss += __shfl_xor(ss, 16); ss += __shfl_xor(ss, 32);
                    if (fq == 0) ss_out[(size_t)row * 16 + u.pn * 4 + wc] = ss;
                }
                EPI_FENCE();
            }
        } else if (mode == 1) {
            const int pn = u.pn;
#pragma unroll
            for (int ai = 0; ai < 2; ++ai) {
                float rs4[4];
#pragma unroll
                for (int m = 0; m < 4; ++m) rs4[m] = rsqrtf(rowstat16(rs_in + (size_t)(rbase + ai * 128 + m * 16) * 16) * (1.f / 1024.f) + EPS);
                EPI_FENCE();
                if (pn < 10) {
#pragma unroll
                    for (int m = 0; m < 4; ++m) {
                        const int row = rbase + ai * 128 + m * 16;
                        const float rs = rs4[m];
                        float ss = 0.f;
#pragma unroll
                        for (int bj = 0; bj < 2; ++bj) {
                            f32x4 v0 = acc[ai][bj][m][0] * rs, v1 = acc[ai][bj][m][1] * rs;
                            if (pn == 0) { v0 = v0 * QS_FOX; v1 = v1 * QS_FOX; }
                            else if (pn == 7 || pn == 8) {
#pragma unroll
                                for (int j = 0; j < 4; ++j) { v0[j] = siluf_(v0[j]); v1[j] = siluf_(v1[j]); }
                            } else if (pn == 9) ss += ((v0[0] * v0[0] + v0[1] * v0[1]) + (v0[2] * v0[2] + v0[3] * v0[3])) + ((v1[0] * v1[0] + v1[1] * v1[1]) + (v1[2] * v1[2] + v1[3] * v1[3]));
                            st8(z + (size_t)row * ZP + colb + bj * 128, v0, v1);
                        }
                        if (pn == 9) { ss += __shfl_xor(ss, 16); ss += __shfl_xor(ss, 32); if (fq == 0) ssq[(size_t)row * 8 + wc] = ss; }
                    }
                } else {
#pragma unroll
                    for (int m = 0; m < 4; ++m) {
                        const int row = rbase + ai * 128 + m * 16;
                        const int pos = row & (SEQ - 1);
                        bf16_t* zr = z + (size_t)row * ZP + 2560;
                        const float rs = rs4[m];
                        {
                            const f32x4 v0 = acc[ai][0][m][0] * rs, v1 = acc[ai][0][m][1] * rs;
                            float ss = ((v0[0] * v0[0] + v0[1] * v0[1]) + (v0[2] * v0[2] + v0[3] * v0[3])) + ((v1[0] * v1[0] + v1[1] * v1[1]) + (v1[2] * v1[2] + v1[3] * v1[3]));
                            st8(zr + wc * 32 + 8 * fq, v0, v1);
                            ss += __shfl_xor(ss, 16); ss += __shfl_xor(ss, 32);
                            if (fq == 0) ssq[(size_t)row * 8 + 4 + wc] = ss;
                        }
                        if (wc == 0) {
                            f32x4 v0 = acc[ai][1][m][0] * rs, v1 = acc[ai][1][m][1] * rs;
                            rope8(v0, v1, pos, fq);
                            st8(zr + 128 + 8 * fq, v0, v1);
                        } else if (wc == 1) {
                            if (fq == 0) { f32x4 v = acc[ai][1][m][0] * rs;
#pragma unroll
                                for (int j = 0; j < 4; ++j) v[j] = logsig(v[j] + bfox[j]) * LOG2E;
                                *(f32x4*)(lf + (size_t)row * 4) = v; }
                            if (fq >= 2) st8(zr + 160 + 8 * fq, acc[ai][1][m][0] * rs, acc[ai][1][m][1] * rs);
                        }
                        EPI_FENCE();
                    }
                }
                EPI_FENCE();
            }
        } else {
#pragma unroll
            for (int ai = 0; ai < 2; ++ai) {
                float rq4[4], rkv4[4];
#pragma unroll
                for (int m = 0; m < 4; ++m) {
                    const float* sp = ssq + (size_t)(rbase + ai * 128 + m * 16) * 8;
                    const f32x4 pq = *(const f32x4*)sp, pk = *(const f32x4*)(sp + 4);
                    rq4[m] = rsqrtf(((pq[0] + pq[1]) + (pq[2] + pq[3])) * (1.f / 256.f) + EPS) * QS_MLA;
                    rkv4[m] = rsqrtf(((pk[0] + pk[1]) + (pk[2] + pk[3])) * (1.f / 128.f) + EPS);
                }
                EPI_FENCE();
#pragma unroll
                for (int m = 0; m < 4; ++m) {
                    const int row = rbase + ai * 128 + m * 16;
                    const int pos = row & (SEQ - 1);
                    const float rq = rq4[m], rkv = rkv4[m];
#pragma unroll
                    for (int bj = 0; bj < 2; ++bj) {
                        const int G = u.pn * 8 + bj * 4 + wc;
                        if (G < 12) {
                            const int head = G / 3, part = G - 3 * head;
                            f32x4 v0 = acc[ai][bj][m][0] * rq, v1 = acc[ai][bj][m][1] * rq;
                            if (part == 2) rope8(v0, v1, pos, fq);
                            st8(qh + (size_t)row * 384 + head * 96 + part * 32 + 8 * fq, v0, v1);
                        } else if (G < 28) {
                            st8(kvb + (size_t)row * 512 + (G - 12) * 32 + 8 * fq, acc[ai][bj][m][0] * rkv, acc[ai][bj][m][1] * rkv);
                        }
                    }
                    EPI_FENCE();
                }
            }
        }
    }
};
struct EpiB {
    static constexpr bool PERM = true, AFTER_DRAIN = false;
    int mode; bf16_t* out; int ldc; float scale; const float* bias; const bf16_t* gate; int first; const float* rs_in;
    __device__ __forceinline__ void operator()(const f32x4 (&acc)[2][2][4][2], const pg8::Unit& u, int wr, int wc, int fr, int fq) const {
        const int rbase = u.pm * 256 + wr * 64 + fr;
        const int colb = u.pn * 256 + wc * 32 + 8 * fq;
        if (mode == 3) {
#pragma unroll
            for (int ai = 0; ai < 2; ++ai) {
                u32x4 g4[4][2], y4[4][2];
#pragma unroll
                for (int m = 0; m < 4; ++m)
#pragma unroll
                    for (int bj = 0; bj < 2; ++bj) {
                        const size_t off = (size_t)(rbase + ai * 128 + m * 16) * ldc + colb + bj * 128;
                        g4[m][bj] = *(const u32x4*)(gate + off);
                        if (!first) y4[m][bj] = *(const u32x4*)(out + off); else y4[m][bj] = (u32x4){0u, 0u, 0u, 0u};
                    }
                EPI_FENCE();
#pragma unroll
                for (int m = 0; m < 4; ++m)
#pragma unroll
                    for (int bj = 0; bj < 2; ++bj) {
                        const size_t off = (size_t)(rbase + ai * 128 + m * 16) * ldc + colb + bj * 128;
                        const u32x4 g = g4[m][bj], y = y4[m][bj];
                        f32x4 v0 = acc[ai][bj][m][0], v1 = acc[ai][bj][m][1];
                        v0[0] = v0[0] * bflo(g.x) + bflo(y.x); v0[1] = v0[1] * bfhi(g.x) + bfhi(y.x); v0[2] = v0[2] * bflo(g.y) + bflo(y.y); v0[3] = v0[3] * bfhi(g.y) + bfhi(y.y);
                        v1[0] = v1[0] * bflo(g.z) + bflo(y.z); v1[1] = v1[1] * bfhi(g.z) + bfhi(y.z); v1[2] = v1[2] * bflo(g.w) + bflo(y.w); v1[3] = v1[3] * bfhi(g.w) + bfhi(y.w);
                        u32x4 w; w.x = pk2(v0[0], v0[1]); w.y = pk2(v0[2], v0[3]); w.z = pk2(v1[0], v1[1]); w.w = pk2(v1[2], v1[3]);
                        *(u32x4*)(out + off) = w;
                    }
                EPI_FENCE();
            }
            return;
        }
#pragma unroll
        for (int ai = 0; ai < 2; ++ai) {
            float rs4[4];
#pragma unroll
            for (int m = 0; m < 4; ++m) rs4[m] = rs_in ? rsqrtf(rowstat16(rs_in + (size_t)(rbase + ai * 128 + m * 16) * 16) * (1.f / 1024.f) + EPS) : 1.f;
            EPI_FENCE();
#pragma unroll
            for (int m = 0; m < 4; ++m) {
                const int row = rbase + ai * 128 + m * 16;
                const float rs = rs4[m];
#pragma unroll
                for (int bj = 0; bj < 2; ++bj) {
                    const int col = colb + bj * 128;
                    const size_t off = (size_t)row * ldc + col;
                    f32x4 v0 = acc[ai][bj][m][0] * rs, v1 = acc[ai][bj][m][1] * rs;
                    if (mode == 0) { v0 = v0 * scale; v1 = v1 * scale; }
                    else if (mode == 1) {
#pragma unroll
                        for (int j = 0; j < 4; ++j) { const float a = fmaxf(v0[j], 0.f), b = fmaxf(v1[j], 0.f); v0[j] = a * a; v1[j] = b * b; }
                    } else {
                        const f32x4 b0 = *(const f32x4*)(bias + col), b1 = *(const f32x4*)(bias + col + 4);
#pragma unroll
                        for (int j = 0; j < 4; ++j) { v0[j] = sigmoidf_(v0[j] + b0[j]); v1[j] = sigmoidf_(v1[j] + b1[j]); }
                    }
                    u32x4 w; w.x = pk2(v0[0], v0[1]); w.y = pk2(v0[2], v0[3]); w.z = pk2(v1[0], v1[1]); w.w = pk2(v1[2], v1[3]);
                    *(u32x4*)(out + off) = w;
                }
            }
            EPI_FENCE();
        }
    }
};

template <class Epi>
DI void run_gemm(LAS unsigned char* lds, const bf16_t* A, int lda, const bf16_t* Bt, int M, int N, int K, const Epi& E, int cshift) {
    pg8::Gemm g; g.A = A; g.Bt = Bt; g.M = M; g.N = N; g.K = K; g.lda = lda;
    pg8::StaticOrder so; so.init(M, N, (int)gridDim.x, (int)((blockIdx.x + cshift) % gridDim.x));
    pg8::gemm_phase<Epi, pg8::StaticOrder, true, true>(lds, g, so, E);
}

struct AttnP {
    const bf16_t* q; int qp;
    const bf16_t* k1; int k1p; const bf16_t* k2; int k2p;
    const bf16_t* v; int vp;
    bf16_t* o; int op;
    const float* bias;
    float kmax;
};
#define ATT_BAR() do { asm volatile("s_waitcnt lgkmcnt(0)" ::: "memory"); __builtin_amdgcn_s_barrier(); asm volatile("" ::: "memory"); } while (0)
template <int DK, int DV, int MODE, int VP = 68>
DI void attn_tile(const LAS unsigned char* kbuf, const LAS unsigned char* vbuf, const LAS float* cb, const int j, const int q0w, const int qrow, const int l32, const int hi, const float cq,
                  const bf16x8 (&qf)[DK / 16], f32x16 (&o)[DV / 32], float& mrun, float& lrun) {
    constexpr int KP = DK + 8;
    f32x16 s0, s1;
#pragma unroll
    for (int r = 0; r < 16; ++r) { s0[r] = 0.f; s1[r] = 0.f; }
    const LAS unsigned char* kb = kbuf + (l32 * KP + 8 * hi) * 2;
    const LAS unsigned char* vb = vbuf + (l32 * VP + 4 * hi) * 2;
    constexpr int KCHK = 2;
#pragma unroll
    for (int c0 = 0; c0 < DK / 16; c0 += KCHK) {
        bf16x8 ka[2][KCHK];
#pragma unroll
        for (int ds = 0; ds < KCHK; ++ds) { ka[0][ds] = *(const LAS bf16x8*)(kb + (c0 + ds) * 32); ka[1][ds] = *(const LAS bf16x8*)(kb + 32 * KP * 2 + (c0 + ds) * 32); }
#pragma unroll
        for (int ds = 0; ds < KCHK; ++ds) { s0 = MFMA32(ka[0][ds], qf[c0 + ds], s0); s1 = MFMA32(ka[1][ds], qf[c0 + ds], s1); }
    }
    if (MODE == 0) {
#pragma unroll
        for (int rq = 0; rq < 4; ++rq) {
            const f32x4 c0 = *(const LAS f32x4*)(cb + 8 * rq + 4 * hi), c1 = *(const LAS f32x4*)(cb + 32 + 8 * rq + 4 * hi);
#pragma unroll
            for (int jj = 0; jj < 4; ++jj) { s0[4 * rq + jj] += cq - c0[jj]; s1[4 * rq + jj] += cq - c1[jj]; }
        }
        if (64 * j + 63 > q0w) {
#pragma unroll
            for (int r = 0; r < 16; ++r) { const int kv = 64 * j + crow(r, hi); if (kv > qrow) s0[r] = -__builtin_inff(); if (kv + 32 > qrow) s1[r] = -__builtin_inff(); }
        }
    }
    float mx = fmaxf(s0[0], s1[0]);
#pragma unroll
    for (int r = 1; r < 16; ++r) mx = fmaxf(mx, fmaxf(s0[r], s1[r]));
    mx = fmaxf(mx, __shfl_xor(mx, 32));
    const float mn = fmaxf(mrun, mx);
    const float alpha = __builtin_amdgcn_exp2f(mrun - mn);
    mrun = mn;
    float ls = 0.f;
#pragma unroll
    for (int r = 0; r < 16; ++r) { s0[r] = __builtin_amdgcn_exp2f(s0[r] - mn); s1[r] = __builtin_amdgcn_exp2f(s1[r] - mn); ls += s0[r] + s1[r]; }
    lrun = lrun * alpha + ls;
#pragma unroll
    for (int i = 0; i < DV / 32; ++i)
#pragma unroll
        for (int r = 0; r < 16; ++r) o[i][r] *= alpha;
    bf16x8 pf[4];
    pf[0] = pack8(s0[0], s0[1], s0[2], s0[3], s0[4], s0[5], s0[6], s0[7]);
    pf[1] = pack8(s0[8], s0[9], s0[10], s0[11], s0[12], s0[13], s0[14], s0[15]);
    pf[2] = pack8(s1[0], s1[1], s1[2], s1[3], s1[4], s1[5], s1[6], s1[7]);
    pf[3] = pack8(s1[8], s1[9], s1[10], s1[11], s1[12], s1[13], s1[14], s1[15]);
#pragma unroll
    for (int dvp = 0; dvp < DV / 32; ++dvp) {
        u32x2 wlo[4], whi[4];
#pragma unroll
        for (int f = 0; f < 4; ++f) {
            const int off = dvp * 32 * VP * 2 + (32 * (f >> 1) + 16 * (f & 1)) * 2;
            wlo[f] = *(const LAS u32x2*)(vb + off); whi[f] = *(const LAS u32x2*)(vb + off + 16);
        }
#pragma unroll
        for (int f = 0; f < 4; ++f) {
            u32x4 av; av.x = wlo[f].x; av.y = wlo[f].y; av.z = whi[f].x; av.w = whi[f].y;
            o[dvp] = MFMA32(__builtin_bit_cast(bf16x8, av), pf[f], o[dvp]);
        }
    }
}

template <int DK, int DV, int MODE, int K1C>
DI void attn_unit(LAS unsigned char* lds, const AttnP& a, const int q0, const int tid_in) {
    int tid = tid_in; asm volatile("" : "+v"(tid));
    constexpr int KP = DK + 8, VP = 68;
    constexpr int KBYTES = 64 * KP * 2, VBYTES = DV * VP * 2;
    constexpr int KCH = DK / 8, NKC = 64 * KCH, KPT = (NKC + 511) / 512;
    constexpr int VCH = DV / 8, NVT = 32 * VCH;
    LAS unsigned char* Kb = lds; LAS unsigned char* Vb = lds + 2 * KBYTES; LAS float* Cb = (LAS float*)(lds + 2 * KBYTES + 2 * VBYTES);
    const int wave = tid >> 6, lane = tid & 63, l32 = lane & 31, hi = lane >> 5;
    const int q0w = q0 + 32 * wave, qrow = q0w + l32;
    int ntiles, wtiles;
    if (MODE == 2) { ntiles = 4; wtiles = 4; }
    else { ntiles = (q0 + 256) / 64; wtiles = (MODE == 0) ? ((q0w + 31) / 64 + 1) : (q0w / 64 + 1); }
    bf16x8 qf[DK / 16];
#pragma unroll
    for (int ds = 0; ds < DK / 16; ++ds) qf[ds] = *(const bf16x8*)(a.q + (size_t)qrow * a.qp + ds * 16 + 8 * hi);
    float cq = 0.f; if (MODE == 0) cq = a.bias[qrow];
    f32x16 o[DV / 32];
#pragma unroll
    for (int i = 0; i < DV / 32; ++i)
#pragma unroll
        for (int r = 0; r < 16; ++r) o[i][r] = 0.f;
    float mrun = -__builtin_inff(), lrun = 0.f;
    u32x4 krA[KPT], krB[KPT]; u32x4 vrA0 = {0, 0, 0, 0}, vrA1 = {0, 0, 0, 0}, vrB0 = {0, 0, 0, 0}, vrB1 = {0, 0, 0, 0}; float crA = 0.f, crB = 0.f;
    const int vkvp = tid / VCH, vdvg = tid % VCH;
#define ATT_GLOAD(S, J) do { \
        _Pragma("unroll") for (int p_ = 0; p_ < KPT; ++p_) { const int ci_ = tid + 512 * p_; if (ci_ < NKC) { const int row_ = ci_ / KCH, cc_ = ci_ % KCH; \
            const bf16_t* src_ = (cc_ < K1C) ? (a.k1 + (size_t)(64 * (J) + row_) * a.k1p + cc_ * 8) : (a.k2 + (size_t)(64 * (J) + row_) * a.k2p + (cc_ - K1C) * 8); \
            kr##S[p_] = *(const u32x4*)src_; } } \
        if (tid < NVT) { const bf16_t* vs_ = a.v + (size_t)(64 * (J) + 2 * vkvp) * a.vp + vdvg * 8; vr##S##0 = *(const u32x4*)vs_; vr##S##1 = *(const u32x4*)(vs_ + a.vp); } \
        if (MODE == 0 && tid < 64) cr##S = a.bias[64 * (J) + tid]; } while (0)
#define ATT_LWRITE(S, B) do { \
        _Pragma("unroll") for (int p_ = 0; p_ < KPT; ++p_) { const int ci_ = tid + 512 * p_; if (ci_ < NKC) { const int row_ = ci_ / KCH, cc_ = ci_ % KCH; \
            *(LAS u32x4*)(Kb + (B) * KBYTES + (row_ * KP + cc_ * 8) * 2) = kr##S[p_]; } } \
        if (tid < NVT) { LAS unsigned char* vd_ = Vb + (B) * VBYTES + ((vdvg * 8) * VP + 2 * vkvp) * 2; \
            _Pragma("unroll") for (int w_ = 0; w_ < 4; ++w_) { \
                *(LAS unsigned*)(vd_ + (2 * w_) * VP * 2) = (vr##S##0[w_] & 0xffffu) | (vr##S##1[w_] << 16); \
                *(LAS unsigned*)(vd_ + (2 * w_ + 1) * VP * 2) = (vr##S##0[w_] >> 16) | (vr##S##1[w_] & 0xffff0000u); } } \
        if (MODE == 0 && tid < 64) Cb[(B) * 64 + tid] = cr##S; } while (0)
    ATT_GLOAD(A, 0);
    ATT_GLOAD(B, 1);
    ATT_LWRITE(A, 0);
    ATT_GLOAD(A, 2);
    for (int j = 0; j < ntiles; j += 2) {
        __syncthreads();
        if (j < wtiles) attn_tile<DK, DV, MODE>(Kb, Vb, Cb, j, q0w, qrow, l32, hi, cq, qf, o, mrun, lrun);
        ATT_LWRITE(B, 1);
        if (j + 3 < ntiles) ATT_GLOAD(B, j + 3);
        __syncthreads();
        if (j + 1 < wtiles) attn_tile<DK, DV, MODE>(Kb + KBYTES, Vb + VBYTES, Cb + 64, j + 1, q0w, qrow, l32, hi, cq, qf, o, mrun, lrun);
        if (j + 2 < ntiles) { ATT_LWRITE(A, 0); if (j + 4 < ntiles) ATT_GLOAD(A, j + 4); }
    }
    __syncthreads();
#undef ATT_GLOAD
#undef ATT_LWRITE
    const float lt = lrun + __shfl_xor(lrun, 32);
    const float inv = 1.0f / lt;
    bf16_t* orow = a.o + (size_t)qrow * a.op + 4 * hi;
#pragma unroll
    for (int dvh = 0; dvh < DV / 32; ++dvh)
#pragma unroll
        for (int rq = 0; rq < 4; ++rq) {
            f32x4 v; v[0] = o[dvh][4 * rq] * inv; v[1] = o[dvh][4 * rq + 1] * inv; v[2] = o[dvh][4 * rq + 2] * inv; v[3] = o[dvh][4 * rq + 3] * inv;
            st4(orow + dvh * 32 + 8 * rq, v);
        }
}

template <int DK>
DI void attn_qk(const LAS unsigned char* kbuf, const int l32, const int hi, const bf16x8 (&qf)[DK / 16], f32x16& s0, f32x16& s1) {
    constexpr int KP = DK + 8;
#pragma unroll
    for (int r = 0; r < 16; ++r) { s0[r] = 0.f; s1[r] = 0.f; }
    const LAS unsigned char* kb = kbuf + (l32 * KP + 8 * hi) * 2;
#pragma unroll
    for (int c0 = 0; c0 < DK / 16; c0 += 2) {
        bf16x8 ka[2][2];
#pragma unroll
        for (int ds = 0; ds < 2; ++ds) { ka[0][ds] = *(const LAS bf16x8*)(kb + (c0 + ds) * 32); ka[1][ds] = *(const LAS bf16x8*)(kb + 32 * KP * 2 + (c0 + ds) * 32); }
#pragma unroll
        for (int ds = 0; ds < 2; ++ds) { s0 = MFMA32(ka[0][ds], qf[c0 + ds], s0); s1 = MFMA32(ka[1][ds], qf[c0 + ds], s1); }
    }
}
template <int DV, int MODE>
DI void attn_sm_pv(f32x16& s0, f32x16& s1, const LAS unsigned char* vbuf, const LAS float* cb, const int j, const int q0w, const int qrow, const int l32, const int hi,
                   f32x16 (&o)[DV / 32], float& mrun, float& lrun) {
    constexpr int VP = 68;
    const LAS unsigned char* vb = vbuf + (l32 * VP + 4 * hi) * 2;
    if (MODE == 0) {
#pragma unroll
        for (int rq = 0; rq < 4; ++rq) {
            const f32x4 c0 = *(const LAS f32x4*)(cb + 8 * rq + 4 * hi), c1 = *(const LAS f32x4*)(cb + 32 + 8 * rq + 4 * hi);
#pragma unroll
            for (int jj = 0; jj < 4; ++jj) { s0[4 * rq + jj] -= c0[jj]; s1[4 * rq + jj] -= c1[jj]; }
        }
        if (64 * j + 63 > q0w) {
#pragma unroll
            for (int r = 0; r < 16; ++r) { const int kv = 64 * j + crow(r, hi); if (kv > qrow) s0[r] = -__builtin_inff(); if (kv + 32 > qrow) s1[r] = -__builtin_inff(); }
        }
    }
    float mx = fmaxf(s0[0], s1[0]);
#pragma unroll
    for (int r = 1; r < 16; ++r) mx = fmaxf(mx, fmaxf(s0[r], s1[r]));
    mx = fmaxf(mx, __shfl_xor(mx, 32));
    const float mn = fmaxf(mrun, mx);
    const float alpha = __builtin_amdgcn_exp2f(mrun - mn);
    mrun = mn;
    float ls = 0.f;
#pragma unroll
    for (int r = 0; r < 16; ++r) { s0[r] = __builtin_amdgcn_exp2f(s0[r] - mn); s1[r] = __builtin_amdgcn_exp2f(s1[r] - mn); ls += s0[r] + s1[r]; }
    lrun = lrun * alpha + ls;
#pragma unroll
    for (int i = 0; i < DV / 32; ++i)
#pragma unroll
        for (int r = 0; r < 16; ++r) o[i][r] *= alpha;
    bf16x8 pf[4];
    pf[0] = pack8(s0[0], s0[1], s0[2], s0[3], s0[4], s0[5], s0[6], s0[7]);
    pf[1] = pack8(s0[8], s0[9], s0[10], s0[11], s0[12], s0[13], s0[14], s0[15]);
    pf[2] = pack8(s1[0], s1[1], s1[2], s1[3], s1[4], s1[5], s1[6], s1[7]);
    pf[3] = pack8(s1[8], s1[9], s1[10], s1[11], s1[12], s1[13], s1[14], s1[15]);
#pragma unroll
    for (int dvp = 0; dvp < DV / 32; dvp += 2) {
        u32x2 wlo[2][4], whi[2][4];
#pragma unroll
        for (int d2 = 0; d2 < 2; ++d2)
#pragma unroll
            for (int f = 0; f < 4; ++f) {
                const int off = (dvp + d2) * 32 * VP * 2 + (32 * (f >> 1) + 16 * (f & 1)) * 2;
                wlo[d2][f] = *(const LAS u32x2*)(vb + off); whi[d2][f] = *(const LAS u32x2*)(vb + off + 16);
            }
#pragma unroll
        for (int d2 = 0; d2 < 2; ++d2)
#pragma unroll
            for (int f = 0; f < 4; ++f) {
                u32x4 av; av.x = wlo[d2][f].x; av.y = wlo[d2][f].y; av.z = whi[d2][f].x; av.w = whi[d2][f].y;
                o[dvp + d2] = MFMA32(__builtin_bit_cast(bf16x8, av), pf[f], o[dvp + d2]);
            }
    }
}
template <int DK, int DV, int MODE, int K1C>
DI void attn_unit_p(LAS unsigned char* lds, const AttnP& a, const int q0, const int tid_in) {
    int tid = tid_in; asm volatile("" : "+v"(tid));
    constexpr int KP = DK + 8, VP = 68;
    constexpr int KBYTES = 64 * KP * 2, VBYTES = DV * VP * 2;
    constexpr int KCH = DK / 8, NKC = 64 * KCH, KPT = (NKC + 511) / 512;
    constexpr int VCH = DV / 8, NVT = 32 * VCH;
    LAS unsigned char* Kb = lds; LAS unsigned char* Vb = lds + 2 * KBYTES; LAS float* Cb = (LAS float*)(lds + 2 * KBYTES + 2 * VBYTES);
    const int wave = tid >> 6, lane = tid & 63, l32 = lane & 31, hi = lane >> 5;
    const int q0w = q0 + 32 * wave, qrow = q0w + l32;
    const int ntiles = (q0 + 256) / 64;
    const int wtiles = (MODE == 0) ? ((q0w + 31) / 64 + 1) : (q0w / 64 + 1);
    bf16x8 qf[DK / 16];
#pragma unroll
    for (int ds = 0; ds < DK / 16; ++ds) qf[ds] = *(const bf16x8*)(a.q + (size_t)qrow * a.qp + ds * 16 + 8 * hi);
    f32x16 o[DV / 32];
#pragma unroll
    for (int i = 0; i < DV / 32; ++i)
#pragma unroll
        for (int r = 0; r < 16; ++r) o[i][r] = 0.f;
    float mrun = -__builtin_inff(), lrun = 0.f;
    u32x4 krA[KPT], krB[KPT]; u32x4 vrA0 = {0, 0, 0, 0}, vrA1 = {0, 0, 0, 0}, vrB0 = {0, 0, 0, 0}, vrB1 = {0, 0, 0, 0}; float crA = 0.f, crB = 0.f;
    const int vkvp = tid / VCH, vdvg = tid % VCH;
#define ATP_GLOADK(S, J) do { if ((J) < ntiles) { \
        _Pragma("unroll") for (int p_ = 0; p_ < KPT; ++p_) { const int ci_ = tid + 512 * p_; if (ci_ < NKC) { const int row_ = ci_ / KCH, cc_ = ci_ % KCH; \
            const bf16_t* src_ = (cc_ < K1C) ? (a.k1 + (size_t)(64 * (J) + row_) * a.k1p + cc_ * 8) : (a.k2 + (size_t)(64 * (J) + row_) * a.k2p + (cc_ - K1C) * 8); \
            kr##S[p_] = *(const u32x4*)src_; } } } } while (0)
#define ATP_GLOADV(S, J) do { if ((J) < ntiles) { \
        if (tid < NVT) { const bf16_t* vs_ = a.v + (size_t)(64 * (J) + 2 * vkvp) * a.vp + vdvg * 8; vr##S##0 = *(const u32x4*)vs_; vr##S##1 = *(const u32x4*)(vs_ + a.vp); } \
        if (MODE == 0 && tid < 64) cr##S = a.bias[64 * (J) + tid]; } } while (0)
#define ATP_LWRITEK(S, B, J) do { if ((J) < ntiles) { \
        _Pragma("unroll") for (int p_ = 0; p_ < KPT; ++p_) { const int ci_ = tid + 512 * p_; if (ci_ < NKC) { const int row_ = ci_ / KCH, cc_ = ci_ % KCH; \
            *(LAS u32x4*)(Kb + (B) * KBYTES + (row_ * KP + cc_ * 8) * 2) = kr##S[p_]; } } } } while (0)
#define ATP_LWRITEV(S, B, J) do { if ((J) < ntiles) { \
        if (tid < NVT) { LAS unsigned char* vd_ = Vb + (B) * VBYTES + ((vdvg * 8) * VP + 2 * vkvp) * 2; \
            _Pragma("unroll") for (int w_ = 0; w_ < 4; ++w_) { \
                *(LAS unsigned*)(vd_ + (2 * w_) * VP * 2) = (vr##S##0[w_] & 0xffffu) | (vr##S##1[w_] << 16); \
                *(LAS unsigned*)(vd_ + (2 * w_ + 1) * VP * 2) = (vr##S##0[w_] >> 16) | (vr##S##1[w_] & 0xffff0000u); } } \
        if (MODE == 0 && tid < 64) Cb[(B) * 64 + tid] = cr##S; } } while (0)
    ATP_GLOADK(A, 0); ATP_GLOADV(A, 0); ATP_GLOADK(B, 1); ATP_GLOADV(B, 1);
    ATP_LWRITEK(A, 0, 0); ATP_LWRITEV(A, 0, 0);
    ATP_GLOADK(A, 2); ATP_GLOADV(A, 2);
    ATT_BAR();
    f32x16 sa0, sa1, sb0, sb1;
    attn_qk<DK>(Kb, l32, hi, qf, sa0, sa1);
    ATP_LWRITEK(B, 1, 1); ATP_GLOADK(B, 3);
    for (int j = 0; j < ntiles; j += 2) {
        ATT_BAR();
        if (j + 1 < wtiles) attn_qk<DK>(Kb + KBYTES, l32, hi, qf, sb0, sb1);
        if (j < wtiles) attn_sm_pv<DV, MODE>(sa0, sa1, Vb, Cb, j, q0w, qrow, l32, hi, o, mrun, lrun);
        ATP_LWRITEK(A, 0, j + 2); ATP_GLOADK(A, j + 4);
        ATP_LWRITEV(B, 1, j + 1); ATP_GLOADV(B, j + 3);
        ATT_BAR();
        if (j + 2 < wtiles) attn_qk<DK>(Kb, l32, hi, qf, sa0, sa1);
        if (j + 1 < wtiles) attn_sm_pv<DV, MODE>(sb0, sb1, Vb + VBYTES, Cb + 64, j + 1, q0w, qrow, l32, hi, o, mrun, lrun);
        ATP_LWRITEK(B, 1, j + 3); ATP_GLOADK(B, j + 5);
        ATP_LWRITEV(A, 0, j + 2); ATP_GLOADV(A, j + 4);
    }
    ATT_BAR();
#undef ATP_GLOADK
#undef ATP_GLOADV
#undef ATP_LWRITEK
#undef ATP_LWRITEV
    const float lt = lrun + __shfl_xor(lrun, 32);
    const float inv = 1.0f / lt;
    bf16_t* orow = a.o + (size_t)qrow * a.op + 4 * hi;
#pragma unroll
    for (int dvh = 0; dvh < DV / 32; ++dvh)
#pragma unroll
        for (int rq = 0; rq < 4; ++rq) {
            f32x4 v; v[0] = o[dvh][4 * rq] * inv; v[1] = o[dvh][4 * rq + 1] * inv; v[2] = o[dvh][4 * rq + 2] * inv; v[3] = o[dvh][4 * rq + 3] * inv;
            st4(orow + dvh * 32 + 8 * rq, v);
        }
}

constexpr int XA_KP = 136, XA_VP = 260, XA_KBYTES = 256 * XA_KP * 2, XA_VBYTES = 128 * XA_VP * 2;
DI void attn_xa_block(LAS unsigned char* lds, const bf16_t* kg, const bf16_t* vg, int kvp, const bf16_t* qg, int qp, bf16_t* og, int op, const int q0, const int nunits, const int tid_in) {
    int tid = tid_in; asm volatile("" : "+v"(tid));
    LAS unsigned char* Kb = lds; LAS unsigned char* Vb = lds + XA_KBYTES;
    const int wave = tid >> 6, lane = tid & 63, l32 = lane & 31, hi = lane >> 5;
#pragma unroll
    for (int p = 0; p < 8; ++p) { const int ci = tid + 512 * p, row = ci >> 4, cc = ci & 15;
        *(LAS u32x4*)(Kb + (row * XA_KP + cc * 8) * 2) = *(const u32x4*)(kg + (size_t)row * kvp + cc * 8); }
#pragma unroll
    for (int p = 0; p < 4; ++p) { const int ci = tid + 512 * p, kp2 = ci >> 4, dvg = ci & 15;
        const bf16_t* vs = vg + (size_t)(2 * kp2) * kvp + dvg * 8; const u32x4 v0 = *(const u32x4*)vs, v1 = *(const u32x4*)(vs + kvp);
        LAS unsigned char* vd = Vb + ((dvg * 8) * XA_VP + 2 * kp2) * 2;
#pragma unroll
        for (int w = 0; w < 4; ++w) { *(LAS unsigned*)(vd + (2 * w) * XA_VP * 2) = (v0[w] & 0xffffu) | (v1[w] << 16); *(LAS unsigned*)(vd + (2 * w + 1) * XA_VP * 2) = (v0[w] >> 16) | (v1[w] & 0xffff0000u); } }
    __syncthreads();
#pragma unroll 1
    for (int un = 0; un < nunits; ++un) {
        const int qrow = q0 + 256 * un + 32 * wave + l32;
        bf16x8 qf[8];
#pragma unroll
        for (int ds = 0; ds < 8; ++ds) qf[ds] = *(const bf16x8*)(qg + (size_t)qrow * qp + ds * 16 + 8 * hi);
        f32x16 o[4];
#pragma unroll
        for (int i = 0; i < 4; ++i)
#pragma unroll
            for (int r = 0; r < 16; ++r) o[i][r] = 0.f;
        float mrun = -__builtin_inff(), lrun = 0.f;
#pragma unroll 1
        for (int j = 0; j < 4; ++j) attn_tile<128, 128, 2, XA_VP>(Kb + j * 64 * XA_KP * 2, Vb + j * 64 * 2, nullptr, j, 0, qrow, l32, hi, 0.f, qf, o, mrun, lrun);
        const float lt = lrun + __shfl_xor(lrun, 32);
        const float inv = 1.0f / lt;
        bf16_t* orow = og + (size_t)qrow * op + 4 * hi;
#pragma unroll
        for (int dvh = 0; dvh < 4; ++dvh)
#pragma unroll
            for (int rq = 0; rq < 4; ++rq) {
                f32x4 v; v[0] = o[dvh][4 * rq] * inv; v[1] = o[dvh][4 * rq + 1] * inv; v[2] = o[dvh][4 * rq + 2] * inv; v[3] = o[dvh][4 * rq + 3] * inv;
                st4(orow + dvh * 32 + 8 * rq, v);
            }
    }
    __syncthreads();
}

template <int DK, int DV, int MODE, int K1C>
DI void attn_unit_s(LAS unsigned char* lds, const AttnP& a, const int q0, const int tid_in) {
    int tid = tid_in; asm volatile("" : "+v"(tid));
    constexpr int KP = DK + 8, VP = 260;
    constexpr int KBYTES = 256 * KP * 2, VBYTES = DV * VP * 2;
    constexpr int KCH = DK / 8, NKC = 256 * KCH, KPT = NKC / 512;
    constexpr int VCH = DV / 8, NVI = 128 * VCH, VPT = NVI / 512;
    LAS unsigned char* Kb = lds; LAS unsigned char* Vb = lds + KBYTES; LAS float* Cb = (LAS float*)(lds + KBYTES + VBYTES);
    const int wave = tid >> 6, lane = tid & 63, l32 = lane & 31, hi = lane >> 5;
    const int q0w = q0 + 32 * wave, qrow = q0w + l32;
    const int nsup = (q0 + 256) / 256;
    const int wtiles = (MODE == 0) ? ((q0w + 31) / 64 + 1) : (q0w / 64 + 1);
    bf16x8 qf[DK / 16];
#pragma unroll
    for (int ds = 0; ds < DK / 16; ++ds) qf[ds] = *(const bf16x8*)(a.q + (size_t)qrow * a.qp + ds * 16 + 8 * hi);
    f32x16 o[DV / 32];
#pragma unroll
    for (int i = 0; i < DV / 32; ++i)
#pragma unroll
        for (int r = 0; r < 16; ++r) o[i][r] = 0.f;
    float mrun = -__builtin_inff(), lrun = 0.f;
    u32x4 kr[KPT], vr[VPT][2]; float cr = 0.f;
#define ATS_GLOAD(S) do { \
        _Pragma("unroll") for (int p_ = 0; p_ < KPT; ++p_) { const int ci_ = tid + 512 * p_, row_ = ci_ / KCH, cc_ = ci_ % KCH; \
            const bf16_t* src_ = (cc_ < K1C) ? (a.k1 + (size_t)(256 * (S) + row_) * a.k1p + cc_ * 8) : (a.k2 + (size_t)(256 * (S) + row_) * a.k2p + (cc_ - K1C) * 8); \
            kr[p_] = *(const u32x4*)src_; } \
        _Pragma("unroll") for (int p_ = 0; p_ < VPT; ++p_) { const int ci_ = tid + 512 * p_, kp2_ = ci_ / VCH, dvg_ = ci_ % VCH; \
            const bf16_t* vs_ = a.v + (size_t)(256 * (S) + 2 * kp2_) * a.vp + dvg_ * 8; vr[p_][0] = *(const u32x4*)vs_; vr[p_][1] = *(const u32x4*)(vs_ + a.vp); } \
        if (MODE == 0 && tid < 256) cr = a.bias[256 * (S) + tid]; } while (0)
#define ATS_LWRITE() do { \
        _Pragma("unroll") for (int p_ = 0; p_ < KPT; ++p_) { const int ci_ = tid + 512 * p_, row_ = ci_ / KCH, cc_ = ci_ % KCH; \
            *(LAS u32x4*)(Kb + (row_ * KP + cc_ * 8) * 2) = kr[p_]; } \
        _Pragma("unroll") for (int p_ = 0; p_ < VPT; ++p_) { const int ci_ = tid + 512 * p_, kp2_ = ci_ / VCH, dvg_ = ci_ % VCH; \
            LAS unsigned char* vd_ = Vb + ((dvg_ * 8) * VP + 2 * kp2_) * 2; \
            _Pragma("unroll") for (int w_ = 0; w_ < 4; ++w_) { \
                *(LAS unsigned*)(vd_ + (2 * w_) * VP * 2) = (vr[p_][0][w_] & 0xffffu) | (vr[p_][1][w_] << 16); \
                *(LAS unsigned*)(vd_ + (2 * w_ + 1) * VP * 2) = (vr[p_][0][w_] >> 16) | (vr[p_][1][w_] & 0xffff0000u); } } \
        if (MODE == 0 && tid < 256) Cb[tid] = cr; } while (0)
    ATS_GLOAD(0);
#pragma unroll 1
    for (int S = 0; S < nsup; ++S) {
        ATT_BAR();
        ATS_LWRITE();
        if (S + 1 < nsup) ATS_GLOAD(S + 1);
        ATT_BAR();
#pragma unroll 1
        for (int t = 0; t < 4; ++t) {
            const int j = 4 * S + t;
            if (j < wtiles) attn_tile<DK, DV, MODE, VP>(Kb + t * 64 * KP * 2, Vb + t * 64 * 2, Cb + 64 * t, j, q0w, qrow, l32, hi, 0.f, qf, o, mrun, lrun);
        }
    }
    ATT_BAR();
#undef ATS_GLOAD
#undef ATS_LWRITE
    const float lt = lrun + __shfl_xor(lrun, 32);
    const float inv = 1.0f / lt;
    bf16_t* orow = a.o + (size_t)qrow * a.op + 4 * hi;
#pragma unroll
    for (int dvh = 0; dvh < DV / 32; ++dvh)
#pragma unroll
        for (int rq = 0; rq < 4; ++rq) {
            f32x4 v; v[0] = o[dvh][4 * rq] * inv; v[1] = o[dvh][4 * rq + 1] * inv; v[2] = o[dvh][4 * rq + 2] * inv; v[3] = o[dvh][4 * rq + 3] * inv;
            st4(orow + dvh * 32 + 8 * rq, v);
        }
}

template <int DK, int DV, int K1C>
DI void attn_unit_fd(LAS unsigned char* lds, const AttnP& a, const int q0, const int tid_in) {
    int tid = tid_in; asm volatile("" : "+v"(tid));
    constexpr int KP = DK + 8, VP = 260;
    constexpr int KBYTES = 256 * KP * 2, VBYTES = DV * VP * 2;
    constexpr int KCH = DK / 8, NKC = 256 * KCH, KPT = NKC / 512;
    constexpr int VCH = DV / 8, NVI = 128 * VCH, VPT = NVI / 512;
    LAS unsigned char* Kb = lds; LAS unsigned char* Vb = lds + KBYTES; LAS float* Cb = (LAS float*)(lds + KBYTES + VBYTES);
    volatile LAS unsigned* vote = (volatile LAS unsigned*)(Cb + 256);
    const int wave = tid >> 6, lane = tid & 63, l32 = lane & 31, hi = lane >> 5;
    const int q0w = q0 + 32 * wave, qrow = q0w + l32;
    const int nsup = (q0 + 256) / 256;
    const int wtiles = (q0w + 31) / 64 + 1;
    bf16x8 qf[DK / 16];
    float qn2 = 0.f;
#pragma unroll
    for (int ds = 0; ds < DK / 16; ++ds) {
        qf[ds] = *(const bf16x8*)(a.q + (size_t)qrow * a.qp + ds * 16 + 8 * hi);
#pragma unroll
        for (int e = 0; e < 8; ++e) { const float v = bf2f((unsigned short)qf[ds][e]); qn2 += v * v; }
    }
    qn2 += __shfl_xor(qn2, 32);
    const float bq = sqrtf(qn2) * a.kmax * 1.0009765625f + 1.0f;
    f32x16 o[DV / 32];
#pragma unroll
    for (int i = 0; i < DV / 32; ++i)
#pragma unroll
        for (int r = 0; r < 16; ++r) o[i][r] = 0.f;
    float mrun = -__builtin_inff(), lrun = 0.f;
    bool done = false;
    u32x4 kr[KPT], vr[VPT][2]; float cr = 0.f;
#define AFD_GLOAD(S) do { \
        _Pragma("unroll") for (int p_ = 0; p_ < KPT; ++p_) { const int ci_ = tid + 512 * p_, row_ = ci_ / KCH, cc_ = ci_ % KCH; \
            kr[p_] = *(const u32x4*)(a.k1 + (size_t)(256 * (S) + row_) * a.k1p + cc_ * 8); } \
        _Pragma("unroll") for (int p_ = 0; p_ < VPT; ++p_) { const int ci_ = tid + 512 * p_, kp2_ = ci_ / VCH, dvg_ = ci_ % VCH; \
            const bf16_t* vs_ = a.v + (size_t)(256 * (S) + 2 * kp2_) * a.vp + dvg_ * 8; vr[p_][0] = *(const u32x4*)vs_; vr[p_][1] = *(const u32x4*)(vs_ + a.vp); } \
        if (tid < 256) cr = a.bias[256 * (S) + tid]; } while (0)
#define AFD_LWRITE() do { \
        _Pragma("unroll") for (int p_ = 0; p_ < KPT; ++p_) { const int ci_ = tid + 512 * p_, row_ = ci_ / KCH, cc_ = ci_ % KCH; \
            *(LAS u32x4*)(Kb + (row_ * KP + cc_ * 8) * 2) = kr[p_]; } \
        _Pragma("unroll") for (int p_ = 0; p_ < VPT; ++p_) { const int ci_ = tid + 512 * p_, kp2_ = ci_ / VCH, dvg_ = ci_ % VCH; \
            LAS unsigned char* vd_ = Vb + ((dvg_ * 8) * VP + 2 * kp2_) * 2; \
            _Pragma("unroll") for (int w_ = 0; w_ < 4; ++w_) { \
                *(LAS unsigned*)(vd_ + (2 * w_) * VP * 2) = (vr[p_][0][w_] & 0xffffu) | (vr[p_][1][w_] << 16); \
                *(LAS unsigned*)(vd_ + (2 * w_ + 1) * VP * 2) = (vr[p_][0][w_] >> 16) | (vr[p_][1][w_] & 0xffff0000u); } } \
        if (tid < 256) Cb[tid] = cr; } while (0)
    AFD_GLOAD(nsup - 1);
#pragma unroll 1
    for (int S = nsup - 1; S >= 0; --S) {
        ATT_BAR();
        if (S != nsup - 1 && vote[S & 1] == 0u) break;
        AFD_LWRITE();
        if (S > 0) AFD_GLOAD(S - 1);
        if (tid == 0) vote[(S + 1) & 1] = 0u;
        ATT_BAR();
#pragma unroll 1
        for (int t = 3; t >= 0; --t) {
            const int j = 4 * S + t;
            if (j < wtiles && !done) {
                const float ub = bq - Cb[64 * t + 63] - mrun;
                if (__all(ub < -64.0f)) done = true;
                else attn_tile<DK, DV, 0, VP>(Kb + t * 64 * KP * 2, Vb + t * 64 * 2, Cb + 64 * t, j, q0w, qrow, l32, hi, 0.f, qf, o, mrun, lrun);
            }
        }
        if (!done && S > 0 && lane == 0) vote[(S - 1) & 1] = 1u;
    }
    ATT_BAR();
#undef AFD_GLOAD
#undef AFD_LWRITE
    const float lt = lrun + __shfl_xor(lrun, 32);
    const float inv = 1.0f / lt;
    bf16_t* orow = a.o + (size_t)qrow * a.op + 4 * hi;
#pragma unroll
    for (int dvh = 0; dvh < DV / 32; ++dvh)
#pragma unroll
        for (int rq = 0; rq < 4; ++rq) {
            f32x4 v; v[0] = o[dvh][4 * rq] * inv; v[1] = o[dvh][4 * rq + 1] * inv; v[2] = o[dvh][4 * rq + 2] * inv; v[3] = o[dvh][4 * rq + 3] * inv;
            st4(orow + dvh * 32 + 8 * rq, v);
        }
}
DI void fox_kmax_item(int item, const bf16_t* z, unsigned* kmax2bits, int tid) {
    const int bh = item >> 3, seg = item & 7, b = bh >> 2, h = bh & 3;
    const bf16_t* kp = z + (size_t)(b * SEQ + seg * 512 + tid) * ZP + ZC_FK + h * 64; float ss = 0.f;
#pragma unroll
    for (int c = 0; c < 8; ++c) { const u32x4 w = *(const u32x4*)(kp + 8 * c);
        ss += (bflo(w.x) * bflo(w.x) + bfhi(w.x) * bfhi(w.x)) + (bflo(w.y) * bflo(w.y) + bfhi(w.y) * bfhi(w.y)) + (bflo(w.z) * bflo(w.z) + bfhi(w.z) * bfhi(w.z)) + (bflo(w.w) * bflo(w.w) + bfhi(w.w) * bfhi(w.w)); }
#pragma unroll
    for (int o = 1; o < 64; o <<= 1) ss = fmaxf(ss, __shfl_xor(ss, o));
    if ((tid & 63) == 0) atomicMax(kmax2bits + bh, __float_as_uint(ss));
}

DI float wave_sum(float v) {
#pragma unroll
    for (int o = 1; o < 64; o <<= 1) v += __shfl_xor(v, o);
    return v;
}
DI void norm_row(const float* xr, const float* g, bf16_t* ob, float* of, int lane) {
    f32x4 v[4]; float ss = 0.f;
#pragma unroll
    for (int j = 0; j < 4; ++j) { v[j] = *(const f32x4*)(xr + 4 * lane + 256 * j); ss += (v[j][0] * v[j][0] + v[j][1] * v[j][1]) + (v[j][2] * v[j][2] + v[j][3] * v[j][3]); }
    const float rstd = rsqrtf(wave_sum(ss) * (1.f / 1024.f) + EPS);
#pragma unroll
    for (int j = 0; j < 4; ++j) {
        const f32x4 gg = *(const f32x4*)(g + 4 * lane + 256 * j);
        const f32x4 y = v[j] * rstd * gg;
        if (ob) st4(ob + 4 * lane + 256 * j, y); else *(f32x4*)(of + 4 * lane + 256 * j) = y;
    }
}
DI void rawnorm_phase(const float* x, bf16_t* ob, float* ssout, int nrows, int tid) {
    const int gw = blockIdx.x * 8 + (tid >> 6), ngw = gridDim.x * 8, lane = tid & 63;
    int r = gw;
    for (; r + 3 * ngw < nrows; r += 4 * ngw) {
        f32x4 v[4][4];
#pragma unroll
        for (int q = 0; q < 4; ++q)
#pragma unroll
            for (int j = 0; j < 4; ++j) v[q][j] = *(const f32x4*)(x + (size_t)(r + q * ngw) * 1024 + 4 * lane + 256 * j);
#pragma unroll
        for (int q = 0; q < 4; ++q) {
            float ss = 0.f;
#pragma unroll
            for (int j = 0; j < 4; ++j) { const f32x4 w = v[q][j]; ss += (w[0] * w[0] + w[1] * w[1]) + (w[2] * w[2] + w[3] * w[3]); st4(ob + (size_t)(r + q * ngw) * 1024 + 4 * lane + 256 * j, w); }
            ss = wave_sum(ss);
            if (lane < 16) ssout[(size_t)(r + q * ngw) * 16 + lane] = (lane == 0) ? ss : 0.f;
        }
    }
    for (; r < nrows; r += ngw) {
        const float* xr = x + (size_t)r * 1024; float ss = 0.f;
#pragma unroll
        for (int j = 0; j < 4; ++j) { const f32x4 v = *(const f32x4*)(xr + 4 * lane + 256 * j); ss += (v[0] * v[0] + v[1] * v[1]) + (v[2] * v[2] + v[3] * v[3]); st4(ob + (size_t)r * 1024 + 4 * lane + 256 * j, v); }
        ss = wave_sum(ss);
        if (lane < 16) ssout[(size_t)r * 16 + lane] = (lane == 0) ? ss : 0.f;
    }
}
DI void norm_phase(const float* x, const float* g, bf16_t* ob, float* of, int nrows, int tid) {
    const int gw = blockIdx.x * 8 + (tid >> 6), ngw = gridDim.x * 8, lane = tid & 63;
    for (int r = gw; r < nrows; r += ngw) norm_row(x + (size_t)r * 1024, g, ob ? ob + (size_t)r * 1024 : nullptr, of ? of + (size_t)r * 1024 : nullptr, lane);
}

DI int map_win(int n) {
    if (n < 768) return n;
    if (n < 1792) return n + 4;
    if (n < 2720) return n + 20;
    if (n < 2724) return 768 + (n - 2720);
    if (n < 2736) return -1;
    if (n < 2752) return 1796 + (n - 2736);
    return -1;
}
DI void transpose_job(const float* src, int Ns, int K, int Nd, int mapmode, int off, bf16_t* dst, LAS float* tile, int tid, int rot, const float* ks = nullptr) {
    const int nkt = K / 64, ntiles = (Nd / 256) * nkt;
    const int G = gridDim.x;
    for (int t = (blockIdx.x + rot) % G; t < ntiles; t += G) {
        const int n0 = (t / nkt) * 256, k0 = (t % nkt) * 64;
        int sc[4];
#pragma unroll
        for (int q = 0; q < 4; ++q) { const int nn = n0 + 64 * q + (tid & 63); sc[q] = mapmode ? map_win(nn) : off + nn; }
#pragma unroll
        for (int p = 0; p < 8; ++p) {
            const int kk = (tid >> 6) + 8 * p;
            const float sk = ks ? ks[k0 + kk] : 1.f;
            const float* sr = src + (size_t)(k0 + kk) * Ns;
#pragma unroll
            for (int q = 0; q < 4; ++q) tile[kk * 257 + 64 * q + (tid & 63)] = (sc[q] >= 0) ? sr[sc[q]] * sk : 0.f;
        }
        __syncthreads();
        const int kc = tid & 7;
#pragma unroll
        for (int q = 0; q < 4; ++q) {
            const int nl = (tid >> 3) + 64 * q;
            const LAS float* s = tile + (kc * 8) * 257 + nl;
            u32x4 w; w.x = pk2(s[0], s[257]); w.y = pk2(s[2 * 257], s[3 * 257]); w.z = pk2(s[4 * 257], s[5 * 257]); w.w = pk2(s[6 * 257], s[7 * 257]);
            *(u32x4*)(dst + (size_t)(n0 + nl) * K + k0 + kc * 8) = w;
        }
        __syncthreads();
    }
}

constexpr size_t WS_CTL = 0;
constexpr size_t WL_WIN = 0, WL_WG = WL_WIN + (size_t)2816 * 1024 * 2, WL_UPF = WL_WG + (size_t)3072 * 1024 * 2, WL_UPG = WL_UPF + (size_t)1024 * 256 * 2,
                 WL_UPM = WL_UPG + (size_t)1024 * 512 * 2, WL_OUT = WL_UPM + (size_t)1024 * 256 * 2, WL_XQ = WL_OUT + (size_t)1024 * 1024 * 2, WL_XKV = WL_XQ + (size_t)512 * 1024 * 2,
                 WL_XO = WL_XKV + (size_t)1024 * 1024 * 2, WL_W1 = WL_XO + (size_t)1024 * 512 * 2, WL_W2 = WL_W1 + (size_t)4096 * 1024 * 2, WL_WM = WL_W2 + (size_t)4096 * 1024 * 2,
                 WL_SIZE = WL_WM + (size_t)1024 * 384 * 2;
constexpr size_t WS_W = 65536;
constexpr size_t WS_LF = WS_W + 2 * WL_SIZE;
constexpr size_t WS_CUM = WS_LF + (size_t)T_TOK * 4 * 4;
constexpr size_t WS_SSQ = WS_CUM + (size_t)T_TOK * 4 * 4;
constexpr size_t WS_GA = WS_SSQ + (size_t)2 * T_TOK * 8 * 4;
constexpr size_t WS_MEMN = WS_GA + (size_t)2048 * 64 * 4;
constexpr size_t WS_KVX = WS_MEMN + (size_t)2 * 2048 * 1024 * 2;
constexpr size_t WS_UT = WS_KVX + (size_t)2 * 2048 * 1024 * 2;
constexpr size_t WS_R0 = WS_UT + (size_t)2048 * 128 * 64 * 2;
constexpr size_t R_Z = WS_R0, R_O = R_Z + (size_t)T_TOK * ZP * 2, R_QH = R_O + (size_t)T_TOK * 1024 * 2, R_KVB = R_QH + (size_t)T_TOK * 384 * 2, R_H = R_KVB + (size_t)T_TOK * 512 * 2,
                 R_END = R_H + (size_t)T_TOK * 1024 * 2;
constexpr size_t R_GTMP = R_Z, R_Y = R_Z + (size_t)T_TOK * 1024 * 2;
constexpr size_t R_QX = R_Z, R_OX = R_Z + (size_t)T_TOK * 512 * 2;
constexpr size_t R_HID = R_Z;
static_assert(R_HID + (size_t)T_TOK * 4096 * 2 <= R_H, "workspace aliasing");
constexpr size_t WS_SSX = R_END;
constexpr size_t WS_NEED = WS_SSX + (size_t)7 * T_TOK * 16 * 4;

struct Params {
    const void* p[28];
};

constexpr int LDS_BYTES = 139264 + 64;
DI const float* inp(const Params& P, int i) { asm volatile("" : "+s"(i)); return (const float*)P.p[i]; }
DI float* outp(const Params& P) { int i = 26; asm volatile("" : "+s"(i)); return (float*)P.p[i]; }
DI unsigned char* wsp(const Params& P) { int i = 27; asm volatile("" : "+s"(i)); return (unsigned char*)P.p[i]; }

DI void gla_a_unit(int unit, const bf16_t* z, const float* wg, const float* bgate, bf16_t* uT, float* ga, int lane) {
    const int b = unit >> 8, h = (unit >> 6) & 3, c = unit & 63;
    const int l32 = lane & 31, hi = lane >> 5;
    const bf16_t* zb = z + (size_t)(b * SEQ + c * 64) * ZP;
    bf16x8 gfr[2];
#pragma unroll
    for (int tt = 0; tt < 2; ++tt) gfr[tt] = *(const bf16x8*)(zb + (size_t)(l32 + 32 * tt) * ZP + ZC_GLOW + 8 * hi);
    unsigned short kraw[2][2][16];
#pragma unroll
    for (int dt = 0; dt < 2; ++dt)
#pragma unroll
        for (int tt = 0; tt < 2; ++tt)
#pragma unroll
            for (int r = 0; r < 16; ++r) kraw[dt][tt][r] = zb[(size_t)(crow(r, hi) + 32 * tt) * ZP + ZC_GK + h * 64 + l32 + 32 * dt];
    bf16x8 vt[2][2];
#define GA_VLOAD(ET) do { const bf16_t* vb_ = zb + ZC_GV + h * 128 + 32 * (ET) + l32 + (size_t)(4 * hi) * ZP; \
        _Pragma("unroll") for (int tt = 0; tt < 2; ++tt) _Pragma("unroll") for (int s = 0; s < 2; ++s) { bf16x8 f_; \
            _Pragma("unroll") for (int j = 0; j < 8; ++j) { const int t_ = (j & 3) + 8 * (2 * s + (j >> 2)) + 32 * tt; f_[j] = (short)vb_[(size_t)t_ * ZP]; } \
            vt[tt][s] = f_; } } while (0)
    GA_VLOAD(0);
    __builtin_amdgcn_sched_barrier(0);
    bf16x8 kd[2][2][2];
#pragma unroll
    for (int dt = 0; dt < 2; ++dt) {
        const int d = l32 + 32 * dt, col = h * 64 + d;
        float wv[8];
#pragma unroll
        for (int j = 0; j < 8; ++j) wv[j] = wg[(8 * hi + j) * 256 + col];
        const bf16x8 wb = pack8(wv[0], wv[1], wv[2], wv[3], wv[4], wv[5], wv[6], wv[7]);
        const float bg = bgate[col];
        f32x16 pre[2];
#pragma unroll
        for (int tt = 0; tt < 2; ++tt) {
            f32x16 zz;
#pragma unroll
            for (int r = 0; r < 16; ++r) zz[r] = 0.f;
            pre[tt] = MFMA32(gfr[tt], wb, zz);
        }
        float tot[8];
#pragma unroll
        for (int tt = 0; tt < 2; ++tt)
#pragma unroll
            for (int q = 0; q < 4; ++q) {
                float run = 0.f;
#pragma unroll
                for (int jj = 0; jj < 4; ++jj) { run += logsig(pre[tt][4 * q + jj] + bg) * (1.f / 16.f); pre[tt][4 * q + jj] = run; }
                tot[4 * tt + q] = run;
            }
        float run = 0.f;
#pragma unroll
        for (int m = 0; m < 8; ++m) {
            const float pm = __shfl_xor(tot[m], 32);
            const float off = run + (hi ? pm : 0.f);
            run += tot[m] + pm;
#pragma unroll
            for (int jj = 0; jj < 4; ++jj) pre[m >> 2][4 * (m & 3) + jj] += off;
        }
        const float end = run;
#pragma unroll
        for (int tt = 0; tt < 2; ++tt)
#pragma unroll
            for (int s = 0; s < 2; ++s) {
                float x[8];
#pragma unroll
                for (int j = 0; j < 8; ++j) { const int r = 8 * s + j; x[j] = bf2f(kraw[dt][tt][r]) * __builtin_amdgcn_exp2f((end - pre[tt][r]) * LOG2E); }
                kd[dt][tt][s] = pack8(x[0], x[1], x[2], x[3], x[4], x[5], x[6], x[7]);
            }
        if (hi == 0) ga[(size_t)unit * 64 + d] = __builtin_amdgcn_exp2f(end * LOG2E);
    }
#pragma unroll
    for (int et = 0; et < 4; ++et) {
        bf16x8 vc[2][2];
#pragma unroll
        for (int tt = 0; tt < 2; ++tt)
#pragma unroll
            for (int s = 0; s < 2; ++s) vc[tt][s] = vt[tt][s];
        if (et + 1 < 4) GA_VLOAD(et + 1);
        __builtin_amdgcn_sched_barrier(0);
#pragma unroll
        for (int dt = 0; dt < 2; ++dt) {
            f32x16 acc;
#pragma unroll
            for (int r = 0; r < 16; ++r) acc[r] = 0.f;
#pragma unroll
            for (int tt = 0; tt < 2; ++tt)
#pragma unroll
                for (int s = 0; s < 2; ++s) acc = MFMA32(kd[dt][tt][s], vc[tt][s], acc);
            bf16_t* up = uT + ((size_t)unit * 128 + 32 * et + l32) * 64 + 32 * dt + 4 * hi;
#pragma unroll
            for (int q4 = 0; q4 < 4; ++q4) { f32x4 v; v[0] = acc[4 * q4]; v[1] = acc[4 * q4 + 1]; v[2] = acc[4 * q4 + 2]; v[3] = acc[4 * q4 + 3]; st4(up + 8 * q4, v); }
        }
        __builtin_amdgcn_sched_barrier(0);
    }
#undef GA_VLOAD
}
DI void gla_b_phase(bf16_t* uT, const float* ga, int tid) {
    for (int gid = blockIdx.x * 512 + tid; gid < 32 * 4096; gid += gridDim.x * 512) {
        const int bh = gid >> 12, idx = gid & 4095, elem = idx * 2, d = elem & 63;
        unsigned* up = (unsigned*)(uT + (size_t)bh * 64 * 8192 + elem);
        const float* ap = ga + (size_t)bh * 64 * 64 + d;
        float s0 = 0.f, s1 = 0.f;
        unsigned u[16]; f32x2 av[16];
#pragma unroll 1
        for (int c0 = 0; c0 < 64; c0 += 16) {
#pragma unroll
            for (int i = 0; i < 16; ++i) { u[i] = up[(size_t)(c0 + i) * 4096]; av[i] = *(const f32x2*)(ap + (c0 + i) * 64); }
#pragma unroll
            for (int i = 0; i < 16; ++i) { s0 = av[i][0] * s0 + bflo(u[i]); s1 = av[i][1] * s1 + bfhi(u[i]); up[(size_t)(c0 + i) * 4096] = pk2(s0, s1); }
        }
    }
}
DI void gla_c_unit(int w, const bf16_t* z, const bf16_t* uT, const float* gout, bf16_t* obuf, int lane) {
    const int bhc = w >> 1, th = w & 1;
    const int b = bhc >> 8, h = (bhc >> 6) & 3, c = bhc & 63;
    const int l32 = lane & 31, hi = lane >> 5;
    const int row = b * SEQ + c * 64 + 32 * th + l32;
    const bf16_t* zr = z + (size_t)row * ZP;
    bf16x8 qb[4];
#pragma unroll
    for (int s = 0; s < 4; ++s) qb[s] = *(const bf16x8*)(zr + ZC_GQ + h * 64 + 16 * s + 8 * hi);
    f32x16 acc[4]; float ss = 0.f;
#pragma unroll
    for (int et = 0; et < 4; ++et) {
#pragma unroll
        for (int r = 0; r < 16; ++r) acc[et][r] = 0.f;
        const bf16_t* sp = uT + ((size_t)bhc * 128 + 32 * et + l32) * 64 + 8 * hi;
#pragma unroll
        for (int s = 0; s < 4; ++s) acc[et] = MFMA32(*(const bf16x8*)(sp + 16 * s), qb[s], acc[et]);
#pragma unroll
        for (int r = 0; r < 16; ++r) ss += acc[et][r] * acc[et][r];
    }
    ss += __shfl_xor(ss, 32);
    const float sc = 0.125f * rsqrtf(ss * (1.f / 8192.f) + EPS);
#pragma unroll
    for (int et = 0; et < 4; ++et)
#pragma unroll
        for (int q4 = 0; q4 < 4; ++q4) {
            const int e0 = 8 * q4 + 4 * hi + 32 * et;
            const f32x4 g = *(const f32x4*)(gout + e0);
            const u32x2 rr = *(const u32x2*)(zr + ZC_GR + h * 128 + e0);
            f32x4 v;
            v[0] = acc[et][4 * q4] * sc * g[0] * bflo(rr.x); v[1] = acc[et][4 * q4 + 1] * sc * g[1] * bfhi(rr.x);
            v[2] = acc[et][4 * q4 + 2] * sc * g[2] * bflo(rr.y); v[3] = acc[et][4 * q4 + 3] * sc * g[3] * bfhi(rr.y);
            st4(obuf + (size_t)row * 1024 + 256 + h * 128 + e0, v);
        }
}
DI void fox_cumsum_block(int bh, const float* lf, float* cum, LAS float* red, int tid) {
    const int b = bh >> 2, h = bh & 3, lane = tid & 63, wave = tid >> 6;
    const float* src = lf + ((size_t)(b * SEQ + tid * 8)) * 4 + h;
    float v[8];
#pragma unroll
    for (int i = 0; i < 8; ++i) v[i] = src[i * 4];
#pragma unroll
    for (int i = 1; i < 8; ++i) v[i] += v[i - 1];
    const float tot = v[7];
    float x = tot;
#pragma unroll
    for (int o = 1; o < 64; o <<= 1) { const float y = __shfl_up(x, o); if (lane >= o) x += y; }
    if (lane == 63) red[wave] = x;
    __syncthreads();
    float base = x - tot;
#pragma unroll
    for (int w = 0; w < 8; ++w) if (w < wave) base += red[w];
    float* dst = cum + (size_t)bh * SEQ + tid * 8;
    f32x4 o0, o1;
#pragma unroll
    for (int i = 0; i < 4; ++i) { o0[i] = v[i] + base; o1[i] = v[4 + i] + base; }
    *(f32x4*)dst = o0; *(f32x4*)(dst + 4) = o1;
    __syncthreads();
}
#define XB_TMO      128
#define XB_XCNT(j)  (256  + 64 * (j))
#define XB_XSUB(j)  (1280 + 64 * (j))
#define XB_XGEN(j)  (2304 + 64 * (j))
#define XB_TOP      3328
#define XB_TOPGEN   3392
#define XCD_BAR_WORDS 3456
#define XB_SPIN_CAP (1u << 18)

__device__ __forceinline__ unsigned xb_ld(unsigned* p)              { return __hip_atomic_load(p, __ATOMIC_RELAXED, __HIP_MEMORY_SCOPE_AGENT); }
__device__ __forceinline__ unsigned xb_add(unsigned* p, unsigned v) { return __hip_atomic_fetch_add(p, v, __ATOMIC_RELAXED, __HIP_MEMORY_SCOPE_AGENT); }
__device__ __forceinline__ unsigned xb_xcc_id() { return (unsigned)__builtin_amdgcn_s_getreg((3 << 11) | 20) & 0xFu; }
#define XB_SPIN(cond, bar) do { unsigned _sp = 0; while (cond) { __builtin_amdgcn_s_sleep(1); \
    if ((++_sp & 255u) == 0u) { if (xb_ld(&(bar)[XB_TMO])) break; if (_sp > XB_SPIN_CAP) { atomicAdd(&(bar)[XB_TMO], 1u); break; } } } } while (0)

struct XcdBarrier {
    unsigned* bar; unsigned x;
    volatile LAS unsigned* st;
};

__device__ __forceinline__ XcdBarrier xcd_barrier_post(unsigned* bar, volatile LAS unsigned* st) {
    XcdBarrier b; b.bar = bar; b.x = xb_xcc_id(); b.st = st;
    if (threadIdx.x == 0) (void)xb_add(&bar[XB_XCNT(b.x)], 1u);
    return b;
}
__device__ __forceinline__ void xcd_barrier_complete(unsigned* bar, unsigned x, unsigned& nloc, unsigned& nx) {
    const unsigned G = gridDim.x * gridDim.y * gridDim.z;
    unsigned sum, cnt, mine, sp = 0u;
    for (;;) {
        sum = 0u; cnt = 0u; mine = 0u;
#pragma unroll
        for (unsigned j = 0; j < 16; ++j) { const unsigned c = xb_ld(&bar[XB_XCNT(j)]); sum += c; cnt += (c > 0u) ? 1u : 0u; mine = (j == x) ? c : mine; }
        if (sum == G) break;
        __builtin_amdgcn_s_sleep(1);
        if ((++sp & 255u) == 0u) { if (xb_ld(&bar[XB_TMO])) break; if (sp > XB_SPIN_CAP) { atomicAdd(&bar[XB_TMO], 1u); break; } }
    }
    nloc = mine > 0u ? mine : 1u; nx = cnt > 0u ? cnt : 1u;
}

__device__ __forceinline__ void xcd_barrier(const XcdBarrier& b) {
    asm volatile("s_waitcnt vmcnt(0)" ::: "memory");
    __syncthreads();
    if (threadIdx.x == 0) {
        unsigned* bar = b.bar;
        __builtin_amdgcn_s_waitcnt(0);
        unsigned nloc = b.st[0], nx = b.st[1];
        if (nloc == 0u) { xcd_barrier_complete(bar, b.x, nloc, nx); b.st[0] = nloc; b.st[1] = nx; }
        const unsigned old = xb_add(&bar[XB_XSUB(b.x)], 1u);
        const unsigned gen = old / nloc;
        if (old + 1u == (gen + 1u) * nloc) {
            __builtin_amdgcn_fence(__ATOMIC_RELEASE, "agent");
            asm volatile("s_waitcnt vmcnt(0)" ::: "memory");
            const unsigned og = xb_add(&bar[XB_TOP], 1u);
            const unsigned tg = og / nx;
            if (og + 1u == (tg + 1u) * nx) xb_add(&bar[XB_TOPGEN], 1u);
            else XB_SPIN(xb_ld(&bar[XB_TOPGEN]) == tg, bar);
            __builtin_amdgcn_fence(__ATOMIC_ACQUIRE, "agent");
            xb_add(&bar[XB_XGEN(b.x)], 1u);
            asm volatile("s_waitcnt vmcnt(0)" ::: "memory");
        } else {
            XB_SPIN(xb_ld(&bar[XB_XGEN(b.x)]) == gen, bar);
            __builtin_amdgcn_fence(__ATOMIC_ACQUIRE, "agent");
            asm volatile("s_waitcnt vmcnt(0)" ::: "memory");
        }
    }
    __syncthreads();

}
DI int ltid() { int t = threadIdx.x; asm volatile("" : "+v"(t)); return t; }
#define PHASE_PRE const int tid = ltid(); const int lane = tid & 63, wave = tid >> 6; const int G = gridDim.x; (void)lane; (void)wave; (void)G;
#define WSPTRS PHASE_PRE \
    unsigned char* ws = wsp(P); float* xres = outp(P); (void)xres; \
    float* lf = (float*)(ws + WS_LF); float* cum = (float*)(ws + WS_CUM); float* ga = (float*)(ws + WS_GA); bf16_t* uT = (bf16_t*)(ws + WS_UT); \
    bf16_t* zb = (bf16_t*)(ws + R_Z); bf16_t* hb = (bf16_t*)(ws + R_H); bf16_t* ob = (bf16_t*)(ws + R_O); bf16_t* qh = (bf16_t*)(ws + R_QH); bf16_t* kvb = (bf16_t*)(ws + R_KVB); \
    bf16_t* gtmp = (bf16_t*)(ws + R_GTMP); bf16_t* yb = (bf16_t*)(ws + R_Y); bf16_t* qx = (bf16_t*)(ws + R_QX); bf16_t* ox = (bf16_t*)(ws + R_OX); \
    bf16_t* hid = (bf16_t*)(ws + R_HID); \
    float* ssx = (float*)(ws + WS_SSX); (void)ssx; \
    const unsigned char* wl = ws + WS_W + (size_t)l * WL_SIZE; float* ssq = (float*)(ws + WS_SSQ) + (size_t)l * T_TOK * 8; bf16_t* kvx = (bf16_t*)(ws + WS_KVX) + (size_t)l * 2048 * 1024; \
    (void)lf; (void)cum; (void)ga; (void)uT; (void)zb; (void)hb; (void)ob; (void)qh; (void)kvb; (void)gtmp; (void)yb; (void)qx; (void)ox; (void)hid; (void)wl; (void)ssq; (void)kvx;
template <int l>
DI void layer_body(const Params& P, LAS unsigned char* lds, const XcdBarrier& bar) {
        { WSPTRS
            EpiA e{}; e.mode = 1; e.z = zb; e.lf = lf; e.ssq = ssq; e.bfox = inp(P, 4) + l * 4; e.rs_in = ssx + (size_t)(l == 0 ? 6 : 2) * T_TOK * 16;
            run_gemm(lds, hb, 1024, (const bf16_t*)(wl + WL_WIN), T_TOK, 2816, 1024, e, 0);
            EpiB e2{}; e2.mode = 0; e2.out = kvx; e2.ldc = 1024; e2.scale = 1.f;
            run_gemm(lds, (const bf16_t*)(ws + WS_MEMN) + (size_t)l * 2048 * 1024, 1024, (const bf16_t*)(wl + WL_XKV), 2048, 1024, 1024, e2, 128);
        }
        xcd_barrier(bar);
        { WSPTRS
            EpiA e{}; e.mode = 2; e.ssq = ssq; e.qh = qh; e.kvb = kvb;
            run_gemm(lds, zb + ZC_MQ, ZP, (const bf16_t*)(wl + WL_WM), T_TOK, 1024, 384, e, 0);
            const float* wg = inp(P, 5) + (size_t)l * 16 * 256; const float* bgate = inp(P, 6) + l * 256;
            for (int u = blockIdx.x * 8 + wave; u < 2048; u += G * 8) gla_a_unit(u, zb, wg, bgate, uT, ga, lane);
            for (int bh = (blockIdx.x + 128) % G; bh < 32; bh += G) fox_cumsum_block(bh, lf, cum, (LAS float*)lds, tid);
            for (int it = blockIdx.x; it < 256; it += G) fox_kmax_item(it, zb, (unsigned*)(ws + WS_CTL + 32768) + l * 32, tid);
        }
        xcd_barrier(bar);
        { WSPTRS
            gla_b_phase(uT, ga, tid);
            for (int vb = blockIdx.x; vb < 256; vb += G) {
                const int xcd = vb & 7, idx = vb >> 3;
                const int bh = xcd * 4 + (idx >> 3), sidx = idx & 7;
                const int b = bh >> 2, h = bh & 3;
                AttnP af; af.q = zb + (size_t)(b * SEQ) * ZP + ZC_FQ + h * 64; af.qp = ZP;
                af.k1 = zb + (size_t)(b * SEQ) * ZP + ZC_FK + h * 64; af.k1p = ZP; af.k2 = af.k1; af.k2p = ZP;
                af.v = zb + (size_t)(b * SEQ) * ZP + ZC_FV + h * 64; af.vp = ZP;
                af.o = ob + (size_t)(b * SEQ) * 1024 + h * 64; af.op = 1024; af.bias = cum + (size_t)bh * SEQ; af.kmax = sqrtf(((const float*)(ws + WS_CTL + 32768))[l * 32 + bh]);
                AttnP am; am.q = qh + (size_t)(b * SEQ) * 384 + h * 96; am.qp = 384;
                am.k1 = kvb + (size_t)(b * SEQ) * 512 + h * 128; am.k1p = 512; am.k2 = zb + (size_t)(b * SEQ) * ZP + ZC_MKR; am.k2p = ZP;
                am.v = kvb + (size_t)(b * SEQ) * 512 + h * 128 + 64; am.vp = 512;
                am.o = ob + (size_t)(b * SEQ) * 1024 + 768 + h * 64; am.op = 1024; am.bias = nullptr; am.kmax = 0.f;
                attn_unit_fd<64, 64, 8>(lds, af, (15 - sidx) * 256, tid);
                attn_unit_s<96, 64, 1, 8>(lds, am, (15 - sidx) * 256, tid);
                attn_unit_fd<64, 64, 8>(lds, af, sidx * 256, tid);
                attn_unit_s<96, 64, 1, 8>(lds, am, sidx * 256, tid);
            }
        }
        xcd_barrier(bar);
        { WSPTRS
            const float* gout = inp(P, 7) + l * 128;
            for (int w = blockIdx.x * 8 + wave; w < 4096; w += G * 8) gla_c_unit(w, zb, uT, gout, ob, lane);
        }
        xcd_barrier(bar);
        { WSPTRS
            const float* bgb = inp(P, 12) + (size_t)l * 3072;
            for (int br = 0; br < 3; ++br) {
                EpiB eg{}; eg.mode = 2; eg.out = gtmp; eg.ldc = 1024; eg.bias = bgb + br * 1024; eg.rs_in = ssx + (size_t)(l == 0 ? 6 : 2) * T_TOK * 16;
                run_gemm(lds, hb, 1024, (const bf16_t*)(wl + WL_WG) + (size_t)br * 1024 * 1024, T_TOK, 1024, 1024, eg, 0);
                EpiB eu{}; eu.mode = 3; eu.out = yb; eu.ldc = 1024; eu.gate = gtmp; eu.first = (br == 0);
                const bf16_t* Ab = ob + (br == 0 ? 0 : (br == 1 ? 256 : 768));
                const bf16_t* Wb = (const bf16_t*)(wl + (br == 0 ? WL_UPF : (br == 1 ? WL_UPG : WL_UPM)));
                run_gemm(lds, Ab, 1024, Wb, T_TOK, 1024, (br == 1) ? 512 : 256, eu, 0);
            }
        }
        xcd_barrier(bar);
        { WSPTRS
            EpiA e{}; e.mode = 0; e.xin_b = hb; e.xout_b = hb; e.ss_out = ssx + (size_t)(l * 3) * T_TOK * 16;
            run_gemm(lds, yb, 1024, (const bf16_t*)(wl + WL_OUT), T_TOK, 1024, 1024, e, 0);
        }
        xcd_barrier(bar);
        { WSPTRS
            EpiB e{}; e.mode = 0; e.out = qx; e.ldc = 512; e.scale = QS_XA; e.rs_in = ssx + (size_t)(l * 3) * T_TOK * 16;
            run_gemm(lds, hb, 1024, (const bf16_t*)(wl + WL_XQ), T_TOK, 512, 1024, e, 0);
        }
        xcd_barrier(bar);
        { WSPTRS
            for (int vb = blockIdx.x; vb < 256; vb += G) {
                const int up = ((vb & 7) << 5) | (vb >> 3);
                const int b = up >> 5, h = (up >> 3) & 3, qp2 = up & 7;
                attn_xa_block(lds, kvx + (size_t)(b * MEMLEN) * 1024 + h * 128, kvx + (size_t)(b * MEMLEN) * 1024 + 512 + h * 128, 1024,
                              qx + (size_t)(b * SEQ) * 512 + h * 128, 512, ox + (size_t)(b * SEQ) * 512 + h * 128, 512, qp2 * 512, 2, tid);
            }
        }
        xcd_barrier(bar);
        { WSPTRS
            EpiA e{}; e.mode = 0; e.xin_b = hb; e.xout_b = hb; e.ss_out = ssx + (size_t)(l * 3 + 1) * T_TOK * 16;
            run_gemm(lds, ox, 512, (const bf16_t*)(wl + WL_XO), T_TOK, 1024, 512, e, 0);
        }
        xcd_barrier(bar);
        { WSPTRS
            EpiB e{}; e.mode = 1; e.out = hid; e.ldc = 4096; e.rs_in = ssx + (size_t)(l * 3 + 1) * T_TOK * 16;
            run_gemm(lds, hb, 1024, (const bf16_t*)(wl + WL_W1), T_TOK, 4096, 1024, e, 0);
        }
        xcd_barrier(bar);
        { WSPTRS
            EpiA e{}; e.mode = 0; e.xin_b = hb; e.xout_b = hb; e.ss_out = ssx + (size_t)(l * 3 + 2) * T_TOK * 16;
            run_gemm(lds, hid, 4096, (const bf16_t*)(wl + WL_W2), T_TOK, 1024, 4096, e, 0);
        }
        xcd_barrier(bar);
        if (l == 0) {
        } else { WSPTRS
            const float* gf = inp(P, 25); const float* ssf = ssx + (size_t)5 * T_TOK * 16;
            const int ngw = G * 8;
            f32x4 gg[4];
#pragma unroll
            for (int jq = 0; jq < 4; ++jq) gg[jq] = *(const f32x4*)(gf + 4 * lane + 256 * jq);
            int r = blockIdx.x * 8 + wave;
            for (; r + 3 * ngw < T_TOK; r += 4 * ngw) {
                float rstd[4]; u32x2 xv[4][4];
#pragma unroll
                for (int q = 0; q < 4; ++q) {
                    rstd[q] = rowstat16(ssf + (size_t)(r + q * ngw) * 16);
#pragma unroll
                    for (int jq = 0; jq < 4; ++jq) xv[q][jq] = *(const u32x2*)(hb + (size_t)(r + q * ngw) * 1024 + 4 * lane + 256 * jq);
                }
#pragma unroll
                for (int q = 0; q < 4; ++q) {
                    const float rs = rsqrtf(rstd[q] * (1.f / 1024.f) + EPS);
#pragma unroll
                    for (int jq = 0; jq < 4; ++jq) {
                        f32x4 y; y[0] = bflo(xv[q][jq].x) * rs * gg[jq][0]; y[1] = bfhi(xv[q][jq].x) * rs * gg[jq][1]; y[2] = bflo(xv[q][jq].y) * rs * gg[jq][2]; y[3] = bfhi(xv[q][jq].y) * rs * gg[jq][3];
                        *(f32x4*)(xres + (size_t)(r + q * ngw) * 1024 + 4 * lane + 256 * jq) = y;
                    }
                }
            }
            for (; r < T_TOK; r += ngw) {
                const float rs = rsqrtf(rowstat16(ssf + (size_t)r * 16) * (1.f / 1024.f) + EPS);
#pragma unroll
                for (int jq = 0; jq < 4; ++jq) {
                    const u32x2 xw = *(const u32x2*)(hb + (size_t)r * 1024 + 4 * lane + 256 * jq);
                    f32x4 y; y[0] = bflo(xw.x) * rs * gg[jq][0]; y[1] = bfhi(xw.x) * rs * gg[jq][1]; y[2] = bflo(xw.y) * rs * gg[jq][2]; y[3] = bfhi(xw.y) * rs * gg[jq][3];
                    *(f32x4*)(xres + (size_t)r * 1024 + 4 * lane + 256 * jq) = y;
                }
            }
        }
}

__global__ void __launch_bounds__(512, 2) fwd_megakernel(Params P) {
    extern __shared__ __attribute__((aligned(16))) unsigned char lds_raw[];
    LAS unsigned char* lds = (LAS unsigned char*)lds_raw;
    cg::grid_group grid = cg::this_grid();
    volatile LAS unsigned* bst = (volatile LAS unsigned*)(lds + 139264);
    if (threadIdx.x == 0) { bst[0] = 0u; bst[1] = 0u; }
    __syncthreads();
    const XcdBarrier bar = xcd_barrier_post((unsigned*)(wsp(P) + WS_CTL), bst);
    {
        PHASE_PRE
        unsigned char* ws = wsp(P); bf16_t* hb = (bf16_t*)(ws + R_H); const float* x_in = inp(P, 0); const float* mem = inp(P, 1);
        float* ssx = (float*)(ws + WS_SSX);
        LAS float* tile = (LAS float*)lds;
        for (int l = 0; l < 2; ++l) {
            unsigned char* wl = ws + WS_W + (size_t)l * WL_SIZE;
            const float* w_in = inp(P, 3) + (size_t)l * 1024 * 5812;
            transpose_job(w_in, 5812, 1024, 2816, 1, 0, (bf16_t*)(wl + WL_WIN), tile, tid, (0 + 144 * l) & 255, inp(P, 2) + l * 1024);
            transpose_job(w_in, 5812, 1024, 3072, 0, 2740, (bf16_t*)(wl + WL_WG), tile, tid, (80 + 144 * l) & 255, inp(P, 2) + l * 1024);
            transpose_job(inp(P, 13) + (size_t)l * 256 * 1024, 1024, 256, 1024, 0, 0, (bf16_t*)(wl + WL_UPF), tile, tid, (144 + 144 * l) & 255);
            transpose_job(inp(P, 14) + (size_t)l * 512 * 1024, 1024, 512, 1024, 0, 0, (bf16_t*)(wl + WL_UPG), tile, tid, (128 + 144 * l) & 255);
            transpose_job(inp(P, 15) + (size_t)l * 256 * 1024, 1024, 256, 1024, 0, 0, (bf16_t*)(wl + WL_UPM), tile, tid, (96 + 144 * l) & 255);
            transpose_job(inp(P, 16) + (size_t)l * 1024 * 1024, 1024, 1024, 1024, 0, 0, (bf16_t*)(wl + WL_OUT), tile, tid, (80 + 144 * l) & 255);
            transpose_job(inp(P, 19) + (size_t)l * 1024 * 512, 512, 1024, 512, 0, 0, (bf16_t*)(wl + WL_XQ), tile, tid, (16 + 144 * l) & 255, inp(P, 17) + l * 1024);
            transpose_job(inp(P, 20) + (size_t)l * 1024 * 1024, 1024, 1024, 1024, 0, 0, (bf16_t*)(wl + WL_XKV), tile, tid, (240 + 144 * l) & 255);
            transpose_job(inp(P, 21) + (size_t)l * 512 * 1024, 1024, 512, 1024, 0, 0, (bf16_t*)(wl + WL_XO), tile, tid, (176 + 144 * l) & 255);
            transpose_job(inp(P, 23) + (size_t)l * 1024 * 4096, 4096, 1024, 4096, 0, 0, (bf16_t*)(wl + WL_W1), tile, tid, (144 + 144 * l) & 255, inp(P, 22) + l * 1024);
            transpose_job(inp(P, 24) + (size_t)l * 4096 * 1024, 1024, 4096, 1024, 0, 0, (bf16_t*)(wl + WL_W2), tile, tid, (144 + 144 * l) & 255);
            bf16_t* wm = (bf16_t*)(wl + WL_WM);
            const float* gq = inp(P, 8) + l * 256; const float* wuq = inp(P, 9) + (size_t)l * 256 * 384;
            const float* gkv = inp(P, 10) + l * 128; const float* wukv = inp(P, 11) + (size_t)l * 128 * 512;
            for (int i = blockIdx.x * 512 + tid; i < 1024 * 384; i += G * 512) {
                const int n = i / 384, k = i - n * 384; float v = 0.f;
                if (n < 384) { if (k < 256) v = gq[k] * wuq[(size_t)k * 384 + n]; }
                else if (n < 896) { if (k >= 256) v = gkv[k - 256] * wukv[(size_t)(k - 256) * 512 + (n - 384)]; }
                wm[i] = (bf16_t)(pk2(v, 0.f) & 0xffffu);
            }
            norm_phase(mem, inp(P, 18) + l * 1024, (bf16_t*)(ws + WS_MEMN) + (size_t)l * 2048 * 1024, nullptr, 2048, tid);
        }
        rawnorm_phase(x_in, hb, ssx + (size_t)6 * T_TOK * 16, T_TOK, tid);
    }
    grid.sync();

    layer_body<0>(P, lds, bar);
    layer_body<1>(P, lds, bar);
}

extern "C" void kernel_launch(void* const* d_in, const int* in_sizes, int n_in, void* d_out, int out_size, void* d_ws, size_t ws_size, hipStream_t stream) {
    static int grid_blocks = 0;
    if (grid_blocks == 0) {
        if (n_in != 26 || ws_size < WS_NEED) { fprintf(stderr, "kernel_launch: expected 26 inputs and >= %zu bytes of workspace (got %d, %zu)\n", (size_t)WS_NEED, n_in, ws_size); grid_blocks = -1; return; }
        int dev = 0, cus = 0, per_cu = 0;
        (void)hipGetDevice(&dev);
        (void)hipDeviceGetAttribute(&cus, hipDeviceAttributeMultiprocessorCount, dev);
        if (hipFuncSetAttribute((const void*)fwd_megakernel, hipFuncAttributeMaxDynamicSharedMemorySize, LDS_BYTES) != hipSuccess) { fprintf(stderr, "kernel_launch: hipFuncSetAttribute failed\n"); grid_blocks = -1; return; }
        if (hipOccupancyMaxActiveBlocksPerMultiprocessor(&per_cu, (const void*)fwd_megakernel, 512, LDS_BYTES) != hipSuccess || per_cu < 1) { fprintf(stderr, "kernel_launch: occupancy query gave %d\n", per_cu); per_cu = 1; }
        (void)hipGetLastError();
        grid_blocks = cus;
    }
    if (grid_blocks < 0) return;
    if (hipMemsetAsync(d_ws, 0, 65536, stream) != hipSuccess) { fprintf(stderr, "kernel_launch: hipMemsetAsync failed\n"); return; }
    Params p{};
    for (int i = 0; i < 26; ++i) p.p[i] = d_in[i];
    p.p[26] = d_out; p.p[27] = d_ws;
    void* args[] = {&p};
    hipError_t e = hipLaunchCooperativeKernel((const void*)fwd_megakernel, dim3(grid_blocks), dim3(512), args, LDS_BYTES, stream);
    if (e != hipSuccess) fprintf(stderr, "cooperative launch failed: %s (grid %d)\n", hipGetErrorString(e), grid_blocks);
}
```
